# Optimizing an MI355X kernel written in HIP

```python
import jax, jax.numpy as jnp
from jax import lax
import numpy as np

D_MODEL = 1024
BATCH = 8
SEQ = 4096
DEPTH = 1

D_MIX = D_MODEL
D_MLSTM = D_MIX // 2
N_MLSTM_HEADS = 4
MLSTM_HEAD_DIM = D_MLSTM // N_MLSTM_HEADS
MLSTM_CHUNK = 128
CONV_W = 3
N_MLA_HEADS = 4
QK_NOPE_DIM = 128
QK_ROPE_DIM = 64
V_HEAD_DIM = 128
D_MLA = N_MLA_HEADS * V_HEAD_DIM
Q_LORA = 256
KV_LORA = 128
ROPE_THETA = 10000.0
Q_BLOCK = 128
N_EXPERTS = 32
TOP_K = 4
D_EXPERT = D_MODEL
SWIGLU_LIMIT = 7.0
SWIGLU_ALPHA = 1.702
D_PLE = 256
EPS = 1e-6

N_GATES = 4 * N_MLSTM_HEADS
OFF_Q = 0
OFF_K = OFF_Q + D_MLSTM
OFF_V = OFF_K + D_MLSTM
OFF_O = OFF_V + D_MLSTM
OFF_G = OFF_O + D_MLSTM
OFF_CQ = OFF_G + N_GATES
OFF_CKV = OFF_CQ + Q_LORA
OFF_KR = OFF_CKV + KV_LORA
D_IN = OFF_KR + QK_ROPE_DIM

kernel_name = "hybrid_mlstm_mla_moe_encoder"


def rms_norm(x, g):
    xf = x.astype(jnp.float32)
    y = xf * lax.rsqrt(jnp.mean(xf * xf, axis=-1, keepdims=True) + EPS)
    return (y * g.astype(jnp.float32)).astype(x.dtype)


def _depthwise_conv(x, w):
    c = x.shape[-1]
    return lax.conv_general_dilated(x, w[:, None, :].astype(x.dtype), window_strides=(1,), padding='SAME',
                                    dimension_numbers=('NWC', 'WIO', 'NWC'), feature_group_count=c)


def _mlstm_state_step(carry, xs):
    c_st, n_st, m_st = carry
    loc_c, loc_n, m_w, b_tot = xs
    m_new = jnp.maximum(b_tot + m_st, m_w)
    a = jnp.exp(b_tot + m_st - m_new)
    c = jnp.exp(m_w - m_new)
    c_new = a[..., None, None] * c_st + c[..., None, None] * loc_c
    n_new = a[..., None] * n_st + c[..., None] * loc_n
    return (c_new, n_new, m_new), (c_st, n_st, m_st)


def _mlstm_direction(q, k, v, ig, fg):
    b_, h_, s_, dh = q.shape
    L = MLSTM_CHUNK
    nc = s_ // L
    q = q.reshape(b_, h_, nc, L, dh)
    k = k.reshape(b_, h_, nc, L, dh)
    v = v.reshape(b_, h_, nc, L, dh)
    ig = ig.reshape(b_, h_, nc, L)
    b = jnp.cumsum(jax.nn.log_sigmoid(fg).reshape(b_, h_, nc, L), axis=-1)
    b_tot = b[..., -1]
    w = b_tot[..., None] - b + ig
    m_w = jnp.max(w, axis=-1)
    kw = k * jnp.exp(w - m_w[..., None])[..., None]
    loc_c = jnp.einsum('bhcsd,bhcse->bhcde', kw, v)
    loc_n = jnp.sum(kw, axis=-2)
    front = lambda a: jnp.moveaxis(a, 2, 0)
    back = lambda a: jnp.moveaxis(a, 0, 2)
    init = (jnp.zeros((b_, h_, dh, dh), jnp.float32), jnp.zeros((b_, h_, dh), jnp.float32),
            jnp.zeros((b_, h_), jnp.float32))
    _, (c_prev, n_prev, m_prev) = lax.scan(_mlstm_state_step, init,
                                           (front(loc_c), front(loc_n), front(m_w), front(b_tot)))
    c_prev, n_prev, m_prev = back(c_prev), back(n_prev), back(m_prev)
    lower = jnp.tril(jnp.ones((L, L), dtype=bool))
    dmat = jnp.where(lower, b[..., :, None] - b[..., None, :] + ig[..., None, :], -jnp.inf)
    inter = b + m_prev[..., None]
    m_t = jnp.maximum(inter, jnp.max(dmat, axis=-1))
    sc = jnp.einsum('bhcld,bhcsd->bhcls', q, k) * jnp.exp(dmat - m_t[..., None])
    a = jnp.exp(inter - m_t)
    num = jnp.einsum('bhcls,bhcse->bhcle', sc, v) + a[..., None] * jnp.einsum('bhcld,bhcde->bhcle', q, c_prev)
    den = jnp.sum(sc, axis=-1) + a * jnp.einsum('bhcld,bhcd->bhcl', q, n_prev)
    h = num / jnp.maximum(jnp.abs(den), jnp.exp(-m_t))[..., None]
    return h.reshape(b_, h_, s_, dh)


def mlstm_group(u, conv_w, conv_b, b_gates, mlstm_norm):
    b_, s_, _ = u.shape
    H, dh = N_MLSTM_HEADS, MLSTM_HEAD_DIM
    qk = jax.nn.silu(_depthwise_conv(u[..., OFF_Q:OFF_V], conv_w) + conv_b)
    q, k = qk[..., :D_MLSTM], qk[..., D_MLSTM:]
    v = u[..., OFF_V:OFF_O]
    o = u[..., OFF_O:OFF_G]
    g = (u[..., OFF_G:OFF_CQ] + b_gates).astype(jnp.float32).reshape(b_, s_, 4, H).transpose(2, 0, 3, 1)
    heads = lambda t: t.reshape(b_, s_, H, dh).transpose(0, 2, 1, 3).astype(jnp.float32)
    q, k, v = heads(q), heads(k) * (dh ** -0.5), heads(v)
    flip = lambda t: jnp.flip(t, axis=2)
    h_f = _mlstm_direction(q, k, v, g[0], g[1])
    h_b = flip(_mlstm_direction(flip(q), flip(k), flip(v), flip(g[2]), flip(g[3])))
    h = (h_f + h_b).transpose(0, 2, 1, 3)
    h = rms_norm(h, mlstm_norm.reshape(H, dh)).reshape(b_, s_, D_MLSTM).astype(u.dtype)
    return h * jax.nn.sigmoid(o)


def _rope(x, cos, sin):
    half = x.shape[-1] // 2
    xf = x.astype(jnp.float32)
    x1, x2 = xf[..., :half], xf[..., half:]
    return jnp.concatenate([x1 * cos - x2 * sin, x2 * cos + x1 * sin], axis=-1).astype(x.dtype)


def mla_group(u, positions, q_norm, w_q_up, kv_norm, w_kv_up, mla_norm):
    b_, s_, _ = u.shape
    H = N_MLA_HEADS
    c_q = rms_norm(u[..., OFF_CQ:OFF_CKV], q_norm)
    q = (c_q @ w_q_up).reshape(b_, s_, H, QK_NOPE_DIM + QK_ROPE_DIM)
    q_nope, q_pe = q[..., :QK_NOPE_DIM], q[..., QK_NOPE_DIM:]
    c_kv = rms_norm(u[..., OFF_CKV:OFF_KR], kv_norm)
    kv = (c_kv @ w_kv_up).reshape(b_, s_, H, QK_NOPE_DIM + V_HEAD_DIM)
    k_nope, v = kv[..., :QK_NOPE_DIM], kv[..., QK_NOPE_DIM:]
    k_pe = u[..., OFF_KR:D_IN]
    freqs = ROPE_THETA ** (-jnp.arange(0, QK_ROPE_DIM, 2, dtype=jnp.float32) / QK_ROPE_DIM)
    ang = positions.astype(jnp.float32)[..., None] * freqs
    cos, sin = jnp.cos(ang), jnp.sin(ang)
    q_pe = _rope(q_pe, cos[:, :, None, :], sin[:, :, None, :])
    k_pe = _rope(k_pe, cos, sin)
    scale = (QK_NOPE_DIM + QK_ROPE_DIM) ** -0.5
    nb = s_ // Q_BLOCK
    qblk = lambda t: t.reshape(b_, nb, Q_BLOCK, H, t.shape[-1]).transpose(1, 0, 3, 2, 4)
    qn_b, qp_b = qblk(q_nope * scale), qblk(q_pe * scale)
    k_nope = k_nope.transpose(0, 2, 1, 3)
    v = v.transpose(0, 2, 1, 3)

    def attend(qs):
        qn, qp = qs
        s = jnp.einsum('bhqd,bhkd->bhqk', qn, k_nope) + jnp.einsum('bhqd,bkd->bhqk', qp, k_pe)
        pr = jax.nn.softmax(s.astype(jnp.float32), axis=-1).astype(v.dtype)
        return jnp.einsum('bhqk,bhkd->bhqd', pr, v)

    o = lax.map(attend, (qn_b, qp_b))
    o = o.transpose(1, 0, 3, 2, 4).reshape(b_, s_, D_MLA)
    return rms_norm(o, mla_norm)


def moe(xn, w_router, b_router, w_gate_up, b_gate_up, w_down, b_down):
    b_, s_, d = xn.shape
    n = b_ * s_
    t = xn.reshape(n, d)
    logits = (t @ w_router + b_router).astype(jnp.float32)
    top_vals, top_idx = lax.top_k(logits, TOP_K)
    gates = jax.nn.softmax(top_vals, axis=-1)
    flat_e = top_idx.reshape(-1)
    flat_tok = jnp.repeat(jnp.arange(n, dtype=jnp.int32), TOP_K)
    order = jnp.argsort(flat_e)
    e_sorted = flat_e[order]
    tok_sorted = flat_tok[order]
    gate_sorted = gates.reshape(-1)[order]
    group_sizes = jnp.bincount(flat_e, length=N_EXPERTS).astype(jnp.int32)
    xs = t[tok_sorted]
    gu = lax.ragged_dot(xs, w_gate_up, group_sizes) + b_gate_up[e_sorted]
    g, up = gu[:, :D_EXPERT], gu[:, D_EXPERT:]
    g = jnp.minimum(g, SWIGLU_LIMIT)
    up = jnp.clip(up, -SWIGLU_LIMIT, SWIGLU_LIMIT)
    hmid = (up + 1) * (g * jax.nn.sigmoid(g * SWIGLU_ALPHA))
    out = lax.ragged_dot(hmid, w_down, group_sizes) + b_down[e_sorted]
    out = out * gate_sorted[:, None].astype(out.dtype)
    y = jax.ops.segment_sum(out, tok_sorted, num_segments=n)
    return y.reshape(b_, s_, d)


def setup_inputs(seed: int = 0) -> dict:
    key = jax.random.key(seed)
    ks = jax.random.split(key, 32)
    nrm = lambda k, shape, s: jax.random.normal(k, shape, jnp.float32) * s
    gain = lambda k, shape: 1.0 + 0.02 * jax.random.normal(k, shape, jnp.float32)
    L = DEPTH
    fb = jnp.linspace(3.0, 6.0, N_MLSTM_HEADS, dtype=jnp.float32)
    zb = jnp.zeros((N_MLSTM_HEADS,), jnp.float32)
    b_gates = jnp.concatenate([zb, fb, zb, fb])[None, :] + nrm(ks[3], (L, N_GATES), 0.1)
    positions = jnp.broadcast_to(jnp.arange(SEQ, dtype=jnp.int32), (BATCH, SEQ))
    return {
        "x": nrm(ks[0], (BATCH, SEQ, D_MODEL), 1.0),
        "p": nrm(ks[1], (DEPTH, BATCH, SEQ, D_PLE), 1.0),
        "positions": positions,
        "attn_norm": gain(ks[2], (L, D_MODEL)),
        "w_in": nrm(ks[4], (L, D_MODEL, D_IN), D_MODEL ** -0.5),
        "b_gates": b_gates,
        "conv_w": nrm(ks[5], (L, CONV_W, 2 * D_MLSTM), CONV_W ** -0.5),
        "conv_b": nrm(ks[6], (L, 2 * D_MLSTM), 0.01),
        "mlstm_norm": gain(ks[7], (L, D_MLSTM)),
        "q_norm": gain(ks[8], (L, Q_LORA)),
        "w_q_up": nrm(ks[9], (L, Q_LORA, N_MLA_HEADS * (QK_NOPE_DIM + QK_ROPE_DIM)), Q_LORA ** -0.5),
        "kv_norm": gain(ks[10], (L, KV_LORA)),
        "w_kv_up": nrm(ks[11], (L, KV_LORA, N_MLA_HEADS * (QK_NOPE_DIM + V_HEAD_DIM)), KV_LORA ** -0.5),
        "mla_norm": gain(ks[12], (L, D_MLA)),
        "w_out": nrm(ks[13], (L, D_MIX, D_MODEL), D_MIX ** -0.5),
        "ffn_norm": gain(ks[14], (L, D_MODEL)),
        "w_router": nrm(ks[15], (L, D_MODEL, N_EXPERTS), D_MODEL ** -0.5),
        "b_router": nrm(ks[16], (L, N_EXPERTS), 0.01),
        "w_gate_up": nrm(ks[17], (L, N_EXPERTS, D_MODEL, 2 * D_EXPERT), D_MODEL ** -0.5),
        "b_gate_up": nrm(ks[18], (L, N_EXPERTS, 2 * D_EXPERT), 0.01),
        "w_down": nrm(ks[19], (L, N_EXPERTS, D_EXPERT, D_MODEL), D_EXPERT ** -0.5),
        "b_down": nrm(ks[20], (L, N_EXPERTS, D_MODEL), 0.01),
        "ple_norm": gain(ks[21], (L, D_MODEL)),
        "w_ple_gate": nrm(ks[22], (L, D_MODEL, D_MODEL), D_MODEL ** -0.5),
        "w_ple_proj": nrm(ks[23], (L, D_PLE, D_MODEL), D_PLE ** -0.5),
        "final_norm": gain(ks[24], (D_MODEL,)),
    }


def reference(x, p, positions, attn_norm, w_in, b_gates, conv_w, conv_b, mlstm_norm, q_norm, w_q_up,
              kv_norm, w_kv_up, mla_norm, w_out, ffn_norm, w_router, b_router, w_gate_up, b_gate_up,
              w_down, b_down, ple_norm, w_ple_gate, w_ple_proj, final_norm):
    h = x
    for i in range(DEPTH):
        a = rms_norm(h, attn_norm[i])
        u = a @ w_in[i]
        y_m = mlstm_group(u, conv_w[i], conv_b[i], b_gates[i], mlstm_norm[i])
        y_a = mla_group(u, positions, q_norm[i], w_q_up[i], kv_norm[i], w_kv_up[i], mla_norm[i])
        h = h + jnp.concatenate([y_m, y_a], axis=-1) @ w_out[i]
        h = h + moe(rms_norm(h, ffn_norm[i]), w_router[i], b_router[i], w_gate_up[i], b_gate_up[i],
                    w_down[i], b_down[i])
        gate = jax.nn.sigmoid(rms_norm(h, ple_norm[i]) @ w_ple_gate[i])
        h = h + gate * (p[i] @ w_ple_proj[i])
    return rms_norm(h, final_norm)
```

```cpp
#include <hip/hip_runtime.h>
#include <cstdio>
#include <cstdint>

#ifndef DBG_MODE
#define DBG_MODE 0
#endif
#ifndef MK_ONE_LAUNCH
#define MK_ONE_LAUNCH 1
#endif

#define LAS __attribute__((address_space(3)))
#define GAS __attribute__((address_space(1)))
typedef unsigned short bf16_t;
typedef short bf16x8 __attribute__((ext_vector_type(8)));
typedef short s16x4 __attribute__((ext_vector_type(4)));
typedef float f32x2 __attribute__((ext_vector_type(2)));
typedef float f32x4 __attribute__((ext_vector_type(4)));
typedef float f32x16 __attribute__((ext_vector_type(16)));
typedef unsigned u32x2 __attribute__((ext_vector_type(2)));
typedef unsigned u32x4 __attribute__((ext_vector_type(4)));

constexpr int NTOK = 32768, DM = 1024, SEQ = 4096, NBATCH = 8;
constexpr int NU = 2560;
constexpr int UC_Q = 0, UC_K = 512, UC_V = 1024, UC_O = 1536, UC_CQ = 2048, UC_CKV = 2304, UC_KR = 2432, UC_G = 2496;
constexpr int NEXP = 32, TOPK = 4, NSLOT = NTOK * TOPK;
constexpr int MAXTILES = 544;
constexpr float EPS = 1e-6f;
constexpr int NPHASE = 13;

constexpr size_t MiB = 1u << 20;
constexpr size_t WS_CTL = 0, CTL_ZERO_BYTES = 1 * MiB;
constexpr size_t CTLB_SSQO = 128 * 1024, CTLB_SSQ1 = 256 * 1024, CTLB_SSQ3 = 384 * 1024;
constexpr size_t WS_WIN = 1 * MiB, WS_WQ = 6 * MiB, WS_WKV = 6 * MiB + 512 * 1024, WS_WOUT = 7 * MiB, WS_WPG = 9 * MiB, WS_WPP = 11 * MiB;
constexpr size_t WS_WGU = 12 * MiB, WS_WDN = 140 * MiB;
constexpr size_t WS_CS = 204 * MiB, WS_G = 212 * MiB, WS_KPE = 214 * MiB, WS_GATEW = 218 * MiB, WS_LIST = 219 * MiB, WS_LOCN = 223 * MiB, WS_MSC = 224 * MiB, WS_PB = 225 * MiB;
constexpr size_t WS_TOPI = 224 * MiB + 512 * 1024;
constexpr size_t WS_XN = 242 * MiB, WS_LOCC = 306 * MiB, WS_Y = 370 * MiB, WS_YS = 242 * MiB;
constexpr size_t WS_U = 498 * MiB, WS_Q = 658 * MiB, WS_KV = 706 * MiB, WS_HMID = 498 * MiB, WS_XN3 = 498 * MiB;
constexpr size_t WS_H1 = 770 * MiB, WS_PP = 898 * MiB, WS_END = 962 * MiB;
constexpr int CW_TMO = 0, CW_BAR = 4096, CW_CNT = 8192;

constexpr int RING_BYTES = 131072;
constexpr int LDS_TAB = 147456;
constexpr int LDS_MISC = LDS_TAB + 4608;
constexpr int LDS_BYTES = LDS_MISC + 256;

#define LDS_WAIT() asm volatile("s_waitcnt lgkmcnt(0)" ::: "memory")
#define VM_WAIT() asm volatile("s_waitcnt vmcnt(0)" ::: "memory")
#define SBAR() __builtin_amdgcn_sched_barrier(0)
__device__ __forceinline__ float bf2f(bf16_t x) { return __uint_as_float((unsigned)x << 16); }
__device__ __forceinline__ float bflo(unsigned w) { return __uint_as_float(w << 16); }
__device__ __forceinline__ float bfhi(unsigned w) { return __uint_as_float(w & 0xffff0000u); }
typedef __bf16 bf16x2n __attribute__((ext_vector_type(2)));
__device__ __forceinline__ unsigned cvt_pk_bf16(float lo, float hi) { const f32x2 v = {lo, hi}; return __builtin_bit_cast(unsigned, __builtin_convertvector(v, bf16x2n)); }
__device__ __forceinline__ float wave_sum(float v) {
#pragma unroll
    for (int o = 1; o < 64; o <<= 1) v += __shfl_xor(v, o);
    return v;
}
__device__ __forceinline__ float fast_exp(float x) { return __builtin_amdgcn_exp2f(x * 1.4426950408889634f); }
__device__ __forceinline__ float sigmoid_f(float x) { return __builtin_amdgcn_rcpf(1.0f + fast_exp(-x)); }

struct Args {
    const float* in[26];
    float* out;
    unsigned char* ws;
    int ph_lo, ph_hi;
};

#define XB_TMO      128
#define XB_XCNT(j)  (256  + 64 * (j))
#define XB_XSUB(j)  (1280 + 64 * (j))
#define XB_XGEN(j)  (2304 + 64 * (j))
#define XB_TOP      3328
#define XB_TOPGEN   3392
#define XCD_BAR_WORDS 3456
#define XB_SPIN_CAP (1u << 20)

__device__ __forceinline__ unsigned xb_ld(unsigned* p)              { return __hip_atomic_load(p, __ATOMIC_RELAXED, __HIP_MEMORY_SCOPE_AGENT); }
__device__ __forceinline__ unsigned xb_add(unsigned* p, unsigned v) { return __hip_atomic_fetch_add(p, v, __ATOMIC_RELAXED, __HIP_MEMORY_SCOPE_AGENT); }
__device__ __forceinline__ unsigned xb_xcc_id() { return (unsigned)__builtin_amdgcn_s_getreg((3 << 11) | 20) & 0xFu; }
#define XB_SPIN(cond, bar) do { unsigned _sp = 0; while (cond) { __builtin_amdgcn_s_sleep(1); \
    if ((++_sp & 255u) == 0u) { if (xb_ld(&(bar)[XB_TMO])) break; if (_sp > XB_SPIN_CAP) { atomicAdd(&(bar)[XB_TMO], 1u); break; } } } } while (0)

struct XcdBarrier { unsigned* bar; unsigned x; volatile LAS unsigned* st; };

__device__ __forceinline__ XcdBarrier xcd_barrier_post(unsigned* bar, volatile LAS unsigned* st) {
    XcdBarrier b; b.bar = bar; b.x = xb_xcc_id(); b.st = st;
    if (threadIdx.x == 0) (void)xb_add(&bar[XB_XCNT(b.x)], 1u);
    return b;
}
__device__ __forceinline__ void xcd_barrier_complete(unsigned* bar, unsigned x, unsigned& nloc, unsigned& nx) {
    const unsigned G = gridDim.x * gridDim.y * gridDim.z;
    unsigned sum, cnt, mine, sp = 0u;
    for (;;) {
        sum = 0u; cnt = 0u; mine = 0u;
#pragma unroll
        for (unsigned j = 0; j < 16; ++j) { const unsigned c = xb_ld(&bar[XB_XCNT(j)]); sum += c; cnt += (c > 0u) ? 1u : 0u; mine = (j == x) ? c : mine; }
        if (sum == G) break;
        __builtin_amdgcn_s_sleep(1);
        if ((++sp & 255u) == 0u) { if (xb_ld(&bar[XB_TMO])) break; if (sp > XB_SPIN_CAP) { atomicAdd(&bar[XB_TMO], 1u); break; } }
    }
    nloc = mine > 0u ? mine : 1u; nx = cnt > 0u ? cnt : 1u;
}
__device__ __forceinline__ void xcd_barrier(const XcdBarrier& b) {
    asm volatile("s_waitcnt vmcnt(0)" ::: "memory");
    __syncthreads();
    if (threadIdx.x == 0) {
        unsigned* bar = b.bar;
        __builtin_amdgcn_s_waitcnt(0);
        unsigned nloc = b.st[0], nx = b.st[1];
        if (nloc == 0u) { xcd_barrier_complete(bar, b.x, nloc, nx); b.st[0] = nloc; b.st[1] = nx; }
        const unsigned old = xb_add(&bar[XB_XSUB(b.x)], 1u);
        const unsigned gen = old / nloc;
        if (old + 1u == (gen + 1u) * nloc) {
            __builtin_amdgcn_fence(__ATOMIC_RELEASE, "agent");
            asm volatile("s_waitcnt vmcnt(0)" ::: "memory");
            const unsigned og = xb_add(&bar[XB_TOP], 1u);
            const unsigned tg = og / nx;
            if (og + 1u == (tg + 1u) * nx) xb_add(&bar[XB_TOPGEN], 1u);
            else XB_SPIN(xb_ld(&bar[XB_TOPGEN]) == tg, bar);
            __builtin_amdgcn_fence(__ATOMIC_ACQUIRE, "agent");
            xb_add(&bar[XB_XGEN(b.x)], 1u);
            asm volatile("s_waitcnt vmcnt(0)" ::: "memory");
        } else {
            XB_SPIN(xb_ld(&bar[XB_XGEN(b.x)]) == gen, bar);
            __builtin_amdgcn_fence(__ATOMIC_ACQUIRE, "agent");
            asm volatile("s_waitcnt vmcnt(0)" ::: "memory");
        }
    }
    __syncthreads();
}

namespace pg8 {
constexpr int BM = 256, BK = 64, HALF = 128, HTB = HALF * BK * 2, STAGE_BYTES = 8 * HTB, NXCD = 8, WGM = 8;
__host__ __device__ __forceinline__ int lds_byte(int r, int c) { const int st = (r >> 4) * 2 + (c >> 5), rr = r & 15, cc = c & 31, ob = rr * 64 + cc * 2; return st * 1024 + (ob ^ (((ob >> 9) & 1) << 5)); }
__host__ __device__ __forceinline__ void stage_rc(int b, int& R, int& C) { const int st = b / 1024, sb = b % 1024, swz = sb ^ (((sb >> 9) & 1) << 5); R = (st >> 1) * 16 + swz / 64; C = (st & 1) * 32 + (swz % 64) / 2; }
__host__ __device__ __forceinline__ int perm32(int rho) { const int n = rho >> 4, i = rho & 15; return 8 * (i >> 2) + 4 * n + (i & 3); }

struct Unit { int pm, pn; };
typedef f32x4 Acc[2][2][4][2];

struct StaticOrder {
    int nM, nN, nwg, G, c;
    __device__ void init(int nM_, int nN_, int G_, int c_) { nM = nM_; nN = nN_; nwg = nM * nN; G = G_; c = c_; }
    __device__ __forceinline__ bool next(int i, Unit& u) const {
        const long L = (long)i * G + c; if (L >= nwg) return false;
        int wgid = (int)L; { const int q = nwg / NXCD, r = nwg % NXCD, xcd = wgid % NXCD, off = wgid / NXCD; wgid = (xcd < r ? xcd * (q + 1) : r * (q + 1) + (xcd - r) * q) + off; }
        const int nig = WGM * nN, gid = wgid / nig, fm = gid * WGM, gsz = (nM - fm) < WGM ? (nM - fm) : WGM;
        u.pm = fm + ((wgid % nig) % gsz); u.pn = (wgid % nig) / gsz; return true;
    }
};

template <class P>
__device__ __forceinline__ void gemm_phase(LAS unsigned char* lds, const P& p) {
    const int tid = threadIdx.x, wid = __builtin_amdgcn_readfirstlane(tid >> 6), lane = tid & 63, wr = wid >> 2, wc = wid & 3, fr = lane & 15, fq = lane >> 4;
    const int nt = p.K / BK;
    int Rr[2]; unsigned cA2[2], voffB[2];
#pragma unroll
    for (int i = 0; i < 2; ++i) { int R, C; stage_rc(tid * 16 + i * 8192, R, C); const int Rb = P::PERM ? ((R & ~31) + perm32(R & 31)) : R;
        Rr[i] = R; cA2[i] = (unsigned)C * 2u; voffB[i] = (unsigned)(Rb * p.ldb + C) * 2u; }
    const size_t kstep = (size_t)(BK * 2);
    const size_t hstepB = (size_t)HALF * p.ldb * 2;
    const unsigned ldsw = (unsigned)wid * 1024u;
    const int aoff = lds_byte(wr * 64 + fr, fq * 8), boff = lds_byte(wc * 32 + fr, fq * 8);
    const char* Ab = p.Abase;
#define PG8_SA(b, h) (((b) * 2 + (h)) * HTB)
#define PG8_SB(b, h) ((4 + (b) * 2 + (h)) * HTB)
#define PG8_STAGE_B(bufoff, gbase) do { _Pragma("unroll") for (int _i = 0; _i < 2; ++_i) \
        __builtin_amdgcn_global_load_lds((const unsigned*)((const char*)(gbase) + voffB[_i]), (LAS unsigned*)(lds + (bufoff) + ldsw + _i * 8192), 16, 0, 0); } while (0)
#define PG8_STAGE_A(bufoff, kb, v0, v1) do { \
        __builtin_amdgcn_global_load_lds((const unsigned*)(Ab + (kb) + (v0)), (LAS unsigned*)(lds + (bufoff) + ldsw), 16, 0, 0); \
        __builtin_amdgcn_global_load_lds((const unsigned*)(Ab + (kb) + (v1)), (LAS unsigned*)(lds + (bufoff) + ldsw + 8192), 16, 0, 0); } while (0)
#define PG8_LDA(dst, b, h) do { _Pragma("unroll") for (int m = 0; m < 4; ++m) _Pragma("unroll") for (int k = 0; k < 2; ++k) dst[m][k] = *(const LAS bf16x8*)(lds + PG8_SA(b, h) + aoff + m * 2048 + k * 1024); } while (0)
#define PG8_LDB(dst, b, h) do { _Pragma("unroll") for (int n = 0; n < 2; ++n) _Pragma("unroll") for (int k = 0; k < 2; ++k) dst[n][k] = *(const LAS bf16x8*)(lds + PG8_SB(b, h) + boff + n * 2048 + k * 1024); } while (0)
#define PG8_MMA(ai, bj, At, Bt) do { __builtin_amdgcn_s_setprio(1); _Pragma("unroll") for (int m = 0; m < 4; ++m) _Pragma("unroll") for (int n = 0; n < 2; ++n) _Pragma("unroll") for (int k = 0; k < 2; ++k) \
        acc[ai][bj][m][n] = __builtin_amdgcn_mfma_f32_16x16x32_bf16(Bt[n][k], At[m][k], acc[ai][bj][m][n], 0, 0, 0); __builtin_amdgcn_s_setprio(0); } while (0)
#define PG8_WAIT_V(n) asm volatile("s_waitcnt vmcnt(" #n ")" ::: "memory")
#define PG8_WAIT_L(n) asm volatile("s_waitcnt lgkmcnt(" #n ")" ::: "memory")
#define PG8_BAR __builtin_amdgcn_s_barrier()
#define PG8_SCHED __builtin_amdgcn_sched_barrier(0)
    Unit cur, nxt; int ui = 0;
    if (!p.next(0, cur)) return;
    Acc acc;
#pragma unroll
    for (int a = 0; a < 2; ++a)
#pragma unroll
        for (int b = 0; b < 2; ++b)
#pragma unroll
            for (int m = 0; m < 4; ++m)
#pragma unroll
                for (int n = 0; n < 2; ++n) acc[a][b][m][n] = (f32x4){0.f, 0.f, 0.f, 0.f};
    bf16x8 At[4][2], B0[2][2], B1[2][2];
    unsigned vc00 = p.a_row_off(cur, Rr[0]) + cA2[0], vc01 = p.a_row_off(cur, Rr[1]) + cA2[1];
    unsigned vc10 = p.a_row_off(cur, HALF + Rr[0]) + cA2[0], vc11 = p.a_row_off(cur, HALF + Rr[1]) + cA2[1];
    const char* cB = p.b_tile(cur);
    PG8_STAGE_B(PG8_SB(0, 0), cB); PG8_STAGE_B(PG8_SB(0, 1), cB + hstepB); PG8_STAGE_A(PG8_SA(0, 0), 0, vc00, vc01); PG8_STAGE_A(PG8_SA(0, 1), 0, vc10, vc11);
    if (wr == 1) PG8_BAR;
    PG8_WAIT_V(2); PG8_BAR;
    PG8_STAGE_B(PG8_SB(1, 0), cB + kstep); PG8_STAGE_A(PG8_SA(1, 0), kstep, vc00, vc01); PG8_STAGE_B(PG8_SB(1, 1), cB + hstepB + kstep);
    PG8_WAIT_V(6); PG8_BAR;
    const int tload = nt >= 4 ? nt - 4 : 0;
    for (;;) {
        const bool has_next = p.next(ui + 1, nxt);
        unsigned vn00 = vc00, vn01 = vc01, vn10 = vc10, vn11 = vc11;
        const char* nB = has_next ? p.b_tile(nxt) : cB;
#pragma unroll 1
        for (int t = 0; t < nt; t += 2) {
            const bool last = (t == nt - 2);
            if (t == tload && has_next) {
                vn00 = p.a_row_off(nxt, Rr[0]) + cA2[0]; vn01 = p.a_row_off(nxt, Rr[1]) + cA2[1];
                vn10 = p.a_row_off(nxt, HALF + Rr[0]) + cA2[0]; vn11 = p.a_row_off(nxt, HALF + Rr[1]) + cA2[1];
            }
            if (p.tmid > 0 && t == p.tmid) p.mid(acc, cur, wr, wc, fr, fq);
            const size_t k1 = (size_t)(t + 1) * kstep, k2 = last ? 0 : (size_t)(t + 2) * kstep, k3 = k2 + kstep;
            const char* b2 = last ? nB : cB + (size_t)(t + 2) * kstep; const char* b3 = b2 + kstep;
            unsigned v200 = vc00, v201 = vc01, v210 = vc10, v211 = vc11;
            if (last) { v200 = vn00; v201 = vn01; v210 = vn10; v211 = vn11; }
            PG8_LDB(B0, 0, 0); PG8_LDB(B1, 0, 1); PG8_SCHED; PG8_LDA(At, 0, 0); PG8_STAGE_A(PG8_SA(1, 1), k1, vc10, vc11);
            PG8_WAIT_V(8); PG8_WAIT_L(0); PG8_BAR; PG8_MMA(0, 0, At, B0); PG8_MMA(0, 1, At, B1); PG8_BAR; PG8_SCHED;
            PG8_LDA(At, 0, 1); PG8_STAGE_B(PG8_SB(0, 0), b2); PG8_STAGE_B(PG8_SB(0, 1), b2 + hstepB); PG8_STAGE_A(PG8_SA(0, 0), k2, v200, v201);
            PG8_WAIT_V(8); PG8_WAIT_L(0); PG8_BAR; PG8_MMA(1, 0, At, B0); PG8_MMA(1, 1, At, B1); PG8_BAR; PG8_SCHED;
            PG8_LDB(B0, 1, 0); PG8_LDB(B1, 1, 1); PG8_SCHED; PG8_LDA(At, 1, 0); PG8_STAGE_A(PG8_SA(0, 1), k2, v210, v211);
            PG8_WAIT_V(8); PG8_WAIT_L(0); PG8_BAR; PG8_MMA(0, 0, At, B0); PG8_MMA(0, 1, At, B1); PG8_BAR; PG8_SCHED;
            PG8_LDA(At, 1, 1); PG8_STAGE_B(PG8_SB(1, 0), b3); PG8_STAGE_B(PG8_SB(1, 1), b3 + hstepB); PG8_STAGE_A(PG8_SA(1, 0), k3, v200, v201);
            PG8_WAIT_V(8); PG8_WAIT_L(0); PG8_BAR; PG8_MMA(1, 0, At, B0); PG8_MMA(1, 1, At, B1); PG8_BAR; PG8_SCHED;
        }
        if (wr == 0) PG8_BAR;
        p.epi(acc, cur, wr, wc, fr, fq);
        if (!has_next) break;
#pragma unroll
        for (int a = 0; a < 2; ++a)
#pragma unroll
            for (int b = 0; b < 2; ++b)
#pragma unroll
                for (int m = 0; m < 4; ++m)
#pragma unroll
                    for (int n = 0; n < 2; ++n) acc[a][b][m][n] = (f32x4){0.f, 0.f, 0.f, 0.f};
        cur = nxt; cB = nB; vc00 = vn00; vc01 = vn01; vc10 = vn10; vc11 = vn11; ++ui;
        if (wr == 1) PG8_BAR;
    }
    PG8_WAIT_V(0);
    PG8_BAR;
#undef PG8_SA
#undef PG8_SB
#undef PG8_STAGE_A
#undef PG8_STAGE_B
#undef PG8_LDA
#undef PG8_LDB
#undef PG8_MMA
#undef PG8_WAIT_V
#undef PG8_WAIT_L
#undef PG8_BAR
#undef PG8_SCHED
}
}
using pg8::Unit; using pg8::Acc;

struct DenseBase {
    const char* Abase; int lda; const bf16_t* Bt; int ldb; int K; int tmid;
    pg8::StaticOrder S;
    __device__ __forceinline__ bool next(int i, Unit& u) const { return S.next(i, u); }
    __device__ __forceinline__ unsigned a_row_off(const Unit& u, int r) const { return (unsigned)((u.pm * 256 + r) * lda) * 2u; }
    __device__ __forceinline__ const char* b_tile(const Unit& u) const { return (const char*)(Bt + (size_t)u.pn * 256 * ldb); }
    __device__ __forceinline__ void mid(Acc&, const Unit&, int, int, int, int) const {}
};

template <bool ROPE> struct ProbBf16 : DenseBase {
    static constexpr bool PERM = true;
    bf16_t* O; int ldc; int rope_pn; const float* cs;
    __device__ __forceinline__ void epi(Acc& acc, const Unit& u, int wr, int wc, int fr, int fq) const {
        asm volatile("" : "+v"(fr), "+v"(fq));
        const int row0 = u.pm * 256 + wr * 64 + fr, colt = u.pn * 256 + wc * 32 + 8 * fq;
        const bool rope = ROPE && (u.pn == rope_pn);
#pragma unroll
        for (int ai = 0; ai < 2; ++ai)
#pragma unroll
            for (int m = 0; m < 4; ++m) { const int row = row0 + ai * 128 + m * 16; bf16_t* rowp = O + (size_t)row * ldc + colt;
#pragma unroll
                for (int bj = 0; bj < 2; ++bj) { f32x4 v0 = acc[ai][bj][m][0], v1 = acc[ai][bj][m][1];
                    if (rope) { const int w = (bj * 128 + wc * 32 + 8 * fq) & 63, i0 = w >> 1;
                        const f32x4 c = *(const f32x4*)(cs + (size_t)row * 64 + i0), s = *(const f32x4*)(cs + (size_t)row * 64 + 32 + i0);
                        f32x4 a, b; a[0] = v0[0] * c[0] - v0[1] * s[0]; a[1] = v0[1] * c[0] + v0[0] * s[0]; a[2] = v0[2] * c[1] - v0[3] * s[1]; a[3] = v0[3] * c[1] + v0[2] * s[1];
                        b[0] = v1[0] * c[2] - v1[1] * s[2]; b[1] = v1[1] * c[2] + v1[0] * s[2]; b[2] = v1[2] * c[3] - v1[3] * s[3]; b[3] = v1[3] * c[3] + v1[2] * s[3]; v0 = a; v1 = b; }
                    u32x4 w4; w4.x = cvt_pk_bf16(v0[0], v0[1]); w4.y = cvt_pk_bf16(v0[2], v0[3]); w4.z = cvt_pk_bf16(v1[0], v1[1]); w4.w = cvt_pk_bf16(v1[2], v1[3]);
                    *(u32x4*)(rowp + bj * 128) = w4; } }
    }
};

struct ProbWout : DenseBase {
    static constexpr bool PERM = false;
    const float* x; float* H1; const float* ssqo; float* ssq1;
    __device__ __forceinline__ void mid(Acc& acc, const Unit& u, int wr, int wc, int fr, int fq) const {
        asm volatile("" : "+v"(fr), "+v"(fq));
#pragma unroll
        for (int ai = 0; ai < 2; ++ai)
#pragma unroll
            for (int m = 0; m < 4; ++m) { const int row = u.pm * 256 + ai * 128 + wr * 64 + m * 16 + fr;
                const float sc = __builtin_amdgcn_rsqf(ssqo[row] * (1.0f / 512.0f) + EPS);
#pragma unroll
                for (int bj = 0; bj < 2; ++bj)
#pragma unroll
                    for (int n = 0; n < 2; ++n) acc[ai][bj][m][n] *= sc; }
    }
    __device__ __forceinline__ void epi(Acc& acc, const Unit& u, int wr, int wc, int fr, int fq) const {
        asm volatile("" : "+v"(fr), "+v"(fq));
        const int row0 = u.pm * 256 + wr * 64 + fr, col0 = u.pn * 256 + wc * 32 + 4 * fq;
#pragma unroll
        for (int ai = 0; ai < 2; ++ai)
#pragma unroll
            for (int m = 0; m < 4; ++m) { const int row = row0 + ai * 128 + m * 16; const size_t off = (size_t)row * DM + col0; float q = 0.f;
#pragma unroll
                for (int bj = 0; bj < 2; ++bj)
#pragma unroll
                    for (int n = 0; n < 2; ++n) { const f32x4 v = *(const f32x4*)(x + off + bj * 128 + n * 16) + (DBG_MODE == 2 ? 0.f : 1.f) * acc[ai][bj][m][n];
                        *(f32x4*)(H1 + off + bj * 128 + n * 16) = v; q += (v[0] * v[0] + v[1] * v[1]) + (v[2] * v[2] + v[3] * v[3]); }
                q += __shfl_xor(q, 16); q += __shfl_xor(q, 32);
                if (fq == 0) atomicAdd(ssq1 + row, q); }
    }
};

struct ProbPle : DenseBase {
    static constexpr bool PERM = false;
    const float* H2; const bf16_t* PP; float* out; float* ssq3;
    __device__ __forceinline__ void epi(Acc& acc, const Unit& u, int wr, int wc, int fr, int fq) const {
        asm volatile("" : "+v"(fr), "+v"(fq));
        const int row0 = u.pm * 256 + wr * 64 + fr, col0 = u.pn * 256 + wc * 32 + 4 * fq;
#pragma unroll
        for (int ai = 0; ai < 2; ++ai)
#pragma unroll
            for (int m = 0; m < 4; ++m) { const int row = row0 + ai * 128 + m * 16; const size_t off = (size_t)row * DM + col0; float q = 0.f;
#pragma unroll
                for (int bj = 0; bj < 2; ++bj)
#pragma unroll
                    for (int n = 0; n < 2; ++n) { const f32x4 h = *(const f32x4*)(H2 + off + bj * 128 + n * 16); const u32x2 pw = *(const u32x2*)(PP + off + bj * 128 + n * 16);
                        const f32x4 a = acc[ai][bj][m][n]; f32x4 v;
                        if (DBG_MODE >= 1) { v = h; } else {
                        v[0] = h[0] + sigmoid_f(a[0]) * bflo(pw.x); v[1] = h[1] + sigmoid_f(a[1]) * bfhi(pw.x); v[2] = h[2] + sigmoid_f(a[2]) * bflo(pw.y); v[3] = h[3] + sigmoid_f(a[3]) * bfhi(pw.y); }
                        *(f32x4*)(out + off + bj * 128 + n * 16) = v; q += (v[0] * v[0] + v[1] * v[1]) + (v[2] * v[2] + v[3] * v[3]); }
                q += __shfl_xor(q, 16); q += __shfl_xor(q, 32);
                if (fq == 0) atomicAdd(ssq3 + row, q); }
    }
};

struct MoeOrder {
    const LAS int* tab; int T, nN, G, c;
    __device__ __forceinline__ bool next(int i, Unit& u) const {
        const int L = i * G + c, x = L & 7, s = L >> 3, q = s / nN; u.pn = s - q * nN; u.pm = x + 8 * q; return u.pm < T;
    }
};
struct ProbMoe1 {
    static constexpr bool PERM = true;
    const char* Abase; const bf16_t* Wgu; int ldb; int K; int tmid; MoeOrder S;
    const int* list; const float* bgu; bf16_t* HMID;
    __device__ __forceinline__ bool next(int i, Unit& u) const { return S.next(i, u); }
    __device__ __forceinline__ unsigned a_row_off(const Unit& u, int r) const {
        const int t0 = S.tab[2 * u.pm], e = t0 & 255, cnt = t0 >> 8, r0 = S.tab[2 * u.pm + 1];
        const int slot = list[e * NTOK + r0 + (r < cnt ? r : 0)];
        return (unsigned)((slot >> 2) * DM) * 2u;
    }
    __device__ __forceinline__ const char* b_tile(const Unit& u) const { const int e = S.tab[2 * u.pm] & 255; return (const char*)(Wgu + ((size_t)e * 2048 + (size_t)u.pn * 256) * DM); }
    __device__ __forceinline__ void mid(Acc&, const Unit&, int, int, int, int) const {}
    __device__ __forceinline__ void epi(Acc& acc, const Unit& u, int wr, int wc, int fr, int fq) const {
        asm volatile("" : "+v"(fr), "+v"(fq));
        const int e = S.tab[2 * u.pm] & 255;
        const int j0 = u.pn * 128 + wc * 32 + 8 * fq;
        const float* bg = bgu + (size_t)e * 2048 + j0;
        const f32x4 bg0 = *(const f32x4*)bg, bg1 = *(const f32x4*)(bg + 4), bu0 = *(const f32x4*)(bg + 1024), bu1 = *(const f32x4*)(bg + 1028);
#pragma unroll
        for (int ai = 0; ai < 2; ++ai)
#pragma unroll
            for (int m = 0; m < 4; ++m) { const int row = u.pm * 256 + ai * 128 + wr * 64 + m * 16 + fr; float h[8];
#pragma unroll
                for (int n = 0; n < 2; ++n) { const f32x4 g4 = acc[ai][0][m][n] + (n ? bg1 : bg0), u4 = acc[ai][1][m][n] + (n ? bu1 : bu0);
#pragma unroll
                    for (int k = 0; k < 4; ++k) { const float g = fminf(g4[k], 7.0f), up = fminf(fmaxf(u4[k], -7.0f), 7.0f); h[n * 4 + k] = (up + 1.0f) * (g * sigmoid_f(1.702f * g)); } }
                u32x4 w4; w4.x = cvt_pk_bf16(h[0], h[1]); w4.y = cvt_pk_bf16(h[2], h[3]); w4.z = cvt_pk_bf16(h[4], h[5]); w4.w = cvt_pk_bf16(h[6], h[7]);
                *(u32x4*)(HMID + (size_t)row * DM + j0) = w4; }
    }
};
struct ProbMoe2 {
    static constexpr bool PERM = true;
    const char* Abase; const bf16_t* Wdn; int ldb; int K; int tmid; MoeOrder S;
    const int* list; const float* bdn; const float* gatew; bf16_t* YS;
    __device__ __forceinline__ bool next(int i, Unit& u) const { return S.next(i, u); }
    __device__ __forceinline__ unsigned a_row_off(const Unit& u, int r) const { return (unsigned)((u.pm * 256 + r) * DM) * 2u; }
    __device__ __forceinline__ const char* b_tile(const Unit& u) const { const int e = S.tab[2 * u.pm] & 255; return (const char*)(Wdn + ((size_t)e * 1024 + (size_t)u.pn * 256) * DM); }
    __device__ __forceinline__ void mid(Acc&, const Unit&, int, int, int, int) const {}
    __device__ __forceinline__ void epi(Acc& acc, const Unit& u, int wr, int wc, int fr, int fq) const {
        asm volatile("" : "+v"(fr), "+v"(fq));
        const int t0 = S.tab[2 * u.pm], e = t0 & 255, cnt = t0 >> 8, r0 = S.tab[2 * u.pm + 1];
        const int colt = u.pn * 256 + wc * 32 + 8 * fq;
        f32x4 bv[2][2];
#pragma unroll
        for (int bj = 0; bj < 2; ++bj)
#pragma unroll
            for (int n = 0; n < 2; ++n) bv[bj][n] = *(const f32x4*)(bdn + (size_t)e * DM + colt + bj * 128 + 4 * n);
#pragma unroll
        for (int ai = 0; ai < 2; ++ai)
#pragma unroll
            for (int m = 0; m < 4; ++m) { const int r = ai * 128 + wr * 64 + m * 16 + fr;
                if (r < cnt) { const int slot = list[e * NTOK + r0 + r]; const float gw = gatew[slot]; bf16_t* rowp = YS + (size_t)slot * DM + colt;
#pragma unroll
                    for (int bj = 0; bj < 2; ++bj) { const f32x4 v0 = (acc[ai][bj][m][0] + bv[bj][0]) * gw, v1 = (acc[ai][bj][m][1] + bv[bj][1]) * gw;
                        u32x4 w4; w4.x = cvt_pk_bf16(v0[0], v0[1]); w4.y = cvt_pk_bf16(v0[2], v0[3]); w4.z = cvt_pk_bf16(v1[0], v1[1]); w4.w = cvt_pk_bf16(v1[2], v1[3]);
                        *(u32x4*)(rowp + bj * 128) = w4; } } }
    }
};

template <class Map, class KS>
__device__ __forceinline__ void tr_item(const float* __restrict__ W, int K, int N, bf16_t* __restrict__ WT, int ldt, int koff, int kmask, LAS float* scr, int item, int lane, Map map, KS ks) {
    const int nblk = (N + 31) >> 5, kb = item / nblk, nb = item - kb * nblk, k0 = 64 * kb, n0 = 32 * nb;
    const int n = n0 + (lane & 31);
#pragma unroll 8
    for (int i = 0; i < 32; ++i) { const int kk = 2 * i + (lane >> 5); float v = 0.f; if (n < N) v = W[(size_t)(k0 + kk) * N + n] * ks(k0 + kk); scr[kk * 33 + (lane & 31)] = v; }
    LDS_WAIT(); asm volatile("" ::: "memory");
    const int c = lane & 7;
#pragma unroll
    for (int j = 0; j < 4; ++j) { const int nn = (lane >> 3) + 8 * j, src = n0 + nn;
        if (src < N) { const LAS float* s = scr + (8 * c) * 33 + nn;
            u32x4 o; o.x = cvt_pk_bf16(s[0 * 33], s[1 * 33]); o.y = cvt_pk_bf16(s[2 * 33], s[3 * 33]); o.z = cvt_pk_bf16(s[4 * 33], s[5 * 33]); o.w = cvt_pk_bf16(s[6 * 33], s[7 * 33]);
            *(u32x4*)(WT + (size_t)map(src) * ldt + ((k0 + 8 * c + koff) & kmask)) = o; } }
    LDS_WAIT(); asm volatile("" ::: "memory");
}
struct KsOne { __device__ __forceinline__ float operator()(int) const { return 1.0f; } };
struct KsWout { const float* g; __device__ __forceinline__ float operator()(int k) const { return k >= 512 ? g[k - 512] : 1.0f; } };
struct MapId { __device__ __forceinline__ int operator()(int n) const { return n; } };
struct MapWin { __device__ __forceinline__ int operator()(int n) const {
    if (n < 2048) return n;
    if (n < 2064) return UC_G + (n - 2048);
    if (n < 2320) return UC_CQ + (n - 2064);
    if (n < 2448) return UC_CKV + (n - 2320);
    const int j = n - 2448; return UC_KR + 2 * (j & 31) + (j >> 5); } };
struct MapWq { __device__ __forceinline__ int operator()(int n) const {
    const int h = n / 192, j = n - h * 192; if (j < 128) return h * 128 + j; const int r = j - 128; return 512 + h * 64 + 2 * (r & 31) + (r >> 5); } };
struct MapWkv { __device__ __forceinline__ int operator()(int n) const {
    const int h = n >> 8, j = n & 255; return j < 128 ? h * 128 + j : 512 + h * 128 + (j - 128); } };
struct MapWgu { __device__ __forceinline__ int operator()(int n) const {
    const int up = n >> 10, j = n & 1023; return 256 * (j >> 7) + 128 * up + (j & 127); } };

__device__ __forceinline__ void p0_prologue(const Args& a, LAS unsigned char* lds, int vcu, int G) {
    const int tid = threadIdx.x, lane = tid & 63, wave = __builtin_amdgcn_readfirstlane(tid >> 6);
    unsigned char* ws = a.ws;
    LAS float* scr = (LAS float*)(lds + wave * 16384);
    const int gw = vcu * 8 + wave, NGW = G * 8;
    bf16_t* WIN = (bf16_t*)(ws + WS_WIN); bf16_t* WQ = (bf16_t*)(ws + WS_WQ); bf16_t* WKV = (bf16_t*)(ws + WS_WKV); bf16_t* WOUT = (bf16_t*)(ws + WS_WOUT);
    bf16_t* WPG = (bf16_t*)(ws + WS_WPG); bf16_t* WPP = (bf16_t*)(ws + WS_WPP); bf16_t* WGU = (bf16_t*)(ws + WS_WGU); bf16_t* WDN = (bf16_t*)(ws + WS_WDN);
    constexpr int I_IN = 16 * 79, I_Q = 4 * 24, I_KV = 2 * 32, I_OUT = 16 * 32, I_PG = 16 * 32, I_PP = 4 * 32, I_GU1 = 16 * 64, I_DN1 = 16 * 32;
    constexpr int I_SMALL = I_IN + I_Q + I_KV + I_OUT + I_PG + I_PP, I_GU = NEXP * I_GU1, I_DN = NEXP * I_DN1, NITEMS = I_SMALL + I_GU + I_DN;
    for (int it = gw; it < NITEMS; it += NGW) {
        int r = it;
        if (r < I_GU) { const int e = r / I_GU1; tr_item(a.in[18] + (size_t)e * 1024 * 2048, 1024, 2048, WGU + (size_t)e * 2048 * 1024, 1024, 0, 0x7fffffff, scr, r - e * I_GU1, lane, MapWgu(), KsOne()); continue; } r -= I_GU;
        if (r < I_DN) { const int e = r / I_DN1; tr_item(a.in[20] + (size_t)e * 1024 * 1024, 1024, 1024, WDN + (size_t)e * 1024 * 1024, 1024, 0, 0x7fffffff, scr, r - e * I_DN1, lane, MapId(), KsOne()); continue; } r -= I_DN;
        if (r < I_IN) { tr_item(a.in[4], 1024, 2512, WIN, 1024, 0, 0x7fffffff, scr, r, lane, MapWin(), KsOne()); continue; } r -= I_IN;
        if (r < I_Q) { tr_item(a.in[10], 256, 768, WQ, 256, 0, 0x7fffffff, scr, r, lane, MapWq(), KsOne()); continue; } r -= I_Q;
        if (r < I_KV) { tr_item(a.in[12], 128, 1024, WKV, 256, 0, 0x7fffffff, scr, r, lane, MapWkv(), KsOne()); continue; } r -= I_KV;
        if (r < I_OUT) { tr_item(a.in[14], 1024, 1024, WOUT, 1024, 512, 1023, scr, r, lane, MapId(), KsWout{a.in[13]}); continue; } r -= I_OUT;
        if (r < I_PG) { tr_item(a.in[23], 1024, 1024, WPG, 1024, 0, 0x7fffffff, scr, r, lane, MapId(), KsOne()); continue; } r -= I_PG;
        tr_item(a.in[24], 256, 1024, WPP, 256, 0, 0x7fffffff, scr, r, lane, MapId(), KsOne());
    }
    const int gt = vcu * 512 + tid, NGT = G * 512;
    for (int i = gt; i < 48 * 1024 / 8; i += NGT) *(u32x4*)(WIN + (size_t)2512 * 1024 + (size_t)i * 8) = (u32x4){0u, 0u, 0u, 0u};
    for (int i = gt; i < 1024 * 16; i += NGT) *(u32x4*)(WKV + (size_t)(i >> 4) * 256 + 128 + (i & 15) * 8) = (u32x4){0u, 0u, 0u, 0u};
    { const float* p = a.in[1]; bf16_t* PB = (bf16_t*)(ws + WS_PB);
      for (int i = gt; i < NTOK * 256 / 8; i += NGT) { const f32x4 x0 = *(const f32x4*)(p + (size_t)i * 8), x1 = *(const f32x4*)(p + (size_t)i * 8 + 4);
          u32x4 o; o.x = cvt_pk_bf16(x0[0], x0[1]); o.y = cvt_pk_bf16(x0[2], x0[3]); o.z = cvt_pk_bf16(x1[0], x1[1]); o.w = cvt_pk_bf16(x1[2], x1[3]); *(u32x4*)(PB + (size_t)i * 8) = o; } }
    { const float* x = a.in[0]; const float* g = a.in[3]; bf16_t* XN = (bf16_t*)(ws + WS_XN);
      f32x4 gv[4];
#pragma unroll
      for (int j = 0; j < 4; ++j) gv[j] = *(const f32x4*)(g + 4 * lane + 256 * j);
      for (int m = gw; m < NTOK; m += NGW) { const f32x4* xr = (const f32x4*)(x + (size_t)m * DM) + lane; f32x4 v[4]; float s = 0.f;
#pragma unroll
          for (int j = 0; j < 4; ++j) { v[j] = xr[64 * j]; s += (v[j][0] * v[j][0] + v[j][1] * v[j][1]) + (v[j][2] * v[j][2] + v[j][3] * v[j][3]); }
          const float rstd = __builtin_amdgcn_rsqf(wave_sum(s) * (1.0f / DM) + EPS);
          u32x2* o8 = (u32x2*)(XN + (size_t)m * DM) + lane;
#pragma unroll
          for (int j = 0; j < 4; ++j) { u32x2 o; o.x = cvt_pk_bf16(v[j][0] * rstd * gv[j][0], v[j][1] * rstd * gv[j][1]); o.y = cvt_pk_bf16(v[j][2] * rstd * gv[j][2], v[j][3] * rstd * gv[j][3]); o8[64 * j] = o; } } }
}

__device__ __forceinline__ void p2_tail(const Args& a, int vcu, int G) {
    const int tid = threadIdx.x, lane = tid & 63, wave = __builtin_amdgcn_readfirstlane(tid >> 6);
    unsigned char* ws = a.ws; const int gw = vcu * 8 + wave, NGW = G * 8;
    bf16_t* U = (bf16_t*)(ws + WS_U); float* CS = (float*)(ws + WS_CS); float* GG = (float*)(ws + WS_G); bf16_t* KPE = (bf16_t*)(ws + WS_KPE);
    const int* positions = (const int*)a.in[2];
    const f32x4 qg = *(const f32x4*)(a.in[9] + 4 * lane); const f32x2 kg = *(const f32x2*)(a.in[11] + 2 * lane);
    const float bgate = lane < 16 ? a.in[5][lane] : 0.f;
    const float freq = __builtin_amdgcn_exp2f(-(float)(lane >> 1) * (13.287712379549449f / 32.0f)) * 0.15915494309189535f;
    for (int m = gw; m < NTOK; m += NGW) {
        bf16_t* ur = U + (size_t)m * NU;
        const u32x2 cqw = *(const u32x2*)(ur + UC_CQ + 4 * lane); const unsigned ckw = *(const unsigned*)(ur + UC_CKV + 2 * lane);
        const float krv = bf2f(ur[UC_KR + lane]); const float gv = lane < 16 ? bf2f(ur[UC_G + lane]) : 0.f;
        const float q0 = bflo(cqw.x), q1 = bfhi(cqw.x), q2 = bflo(cqw.y), q3 = bfhi(cqw.y), k0 = bflo(ckw), k1 = bfhi(ckw);
        const float rq = __builtin_amdgcn_rsqf(wave_sum((q0 * q0 + q1 * q1) + (q2 * q2 + q3 * q3)) * (1.0f / 256.0f) + EPS);
        const float rk = __builtin_amdgcn_rsqf(wave_sum(k0 * k0 + k1 * k1) * (1.0f / 128.0f) + EPS);
        u32x2 qo; qo.x = cvt_pk_bf16(q0 * rq * qg[0], q1 * rq * qg[1]); qo.y = cvt_pk_bf16(q2 * rq * qg[2], q3 * rq * qg[3]);
        *(u32x2*)(ur + UC_CQ + 4 * lane) = qo; *(unsigned*)(ur + UC_CKV + 2 * lane) = cvt_pk_bf16(k0 * rk * kg[0], k1 * rk * kg[1]);
        float rev = (float)positions[m] * freq; rev -= __builtin_rintf(rev);
        const float cs = __builtin_amdgcn_cosf(rev), sn = __builtin_amdgcn_sinf(rev);
        const float other = __shfl_xor(krv, 1);
        const float ro = (lane & 1) ? (krv * cs + other * sn) : (krv * cs - other * sn);
        const unsigned rw = cvt_pk_bf16(ro, __shfl_xor(ro, 1));
        if (!(lane & 1)) { *(unsigned*)(KPE + (size_t)m * 64 + lane) = rw; CS[(size_t)m * 64 + (lane >> 1)] = cs; CS[(size_t)m * 64 + 32 + (lane >> 1)] = sn; }
        if (lane < 16) { float g = gv + bgate; if ((lane >> 2) & 1) g = fminf(g, 0.f) - __logf(1.0f + __expf(-fabsf(g))); GG[(size_t)m * 16 + lane] = g; }
    }
}

constexpr int LDP = 136;
constexpr int IMG = 128 * LDP * 2;
__device__ __forceinline__ unsigned lds_addr(const LAS void* p) { return (unsigned)(unsigned long)p; }
__device__ __forceinline__ bf16x8 frag_row(const LAS bf16_t* img, int row, int col) { return *(const LAS bf16x8*)(img + row * LDP + col); }
__device__ __forceinline__ void frag_tr_issue(const LAS bf16_t* img, int k0, int x0, int lane, s16x4& lo, s16x4& hi) {
    const int g = lane >> 4, i = lane & 15, q = i >> 2, p = i & 3;
    const unsigned ad = lds_addr(img + (k0 + 8 * g + q) * LDP + x0 + 4 * p);
    asm volatile("ds_read_b64_tr_b16 %0, %1" : "=v"(lo) : "v"(ad) : "memory");
    asm volatile("ds_read_b64_tr_b16 %0, %1 offset:%2" : "=v"(hi) : "v"(ad), "i"(4 * LDP * 2) : "memory");
}
#define PK8(L, H) (bf16x8){L[0], L[1], L[2], L[3], H[0], H[1], H[2], H[3]}

template <bool MAX> __device__ __forceinline__ void scan128(float a0, float a1, int lane, float& o0, float& o1) {
    float inc = MAX ? fmaxf(a0, a1) : a0 + a1;
#pragma unroll
    for (int off = 1; off < 64; off <<= 1) { const float y = __shfl_up(inc, off); if (lane >= off) inc = MAX ? fmaxf(inc, y) : inc + y; }
    float ex = __shfl_up(inc, 1); if (lane == 0) ex = MAX ? -INFINITY : 0.f;
    o0 = MAX ? fmaxf(ex, a0) : ex + a0; o1 = MAX ? fmaxf(o0, a1) : o0 + a1;
}
struct GateLds { LAS float* gi; LAS float* bc; LAS float* gg; LAS float* cm; LAS float* ee; LAS float* sc; };
__device__ __forceinline__ GateLds gate_lds(LAS unsigned char* base) {
    GateLds g; g.gi = (LAS float*)base; g.bc = g.gi + 512; g.gg = g.bc + 256; g.cm = g.gg + 256; g.ee = g.cm + 256; g.sc = g.ee + 256; return g;
}
__device__ __forceinline__ void gate_scans(const GateLds& L, int wave, int lane) {
    if (wave < 2) {
        const int d = wave, t0 = d ? 127 - 2 * lane : 2 * lane, t1 = d ? 126 - 2 * lane : 2 * lane + 1;
        const float i0 = L.gi[256 * d + t0], i1 = L.gi[256 * d + t1], f0 = L.gi[256 * d + 128 + t0], f1 = L.gi[256 * d + 128 + t1];
        float b0, b1; scan128<false>(f0, f1, lane, b0, b1);
        const float g0 = i0 - b0, g1 = i1 - b1; float c0, c1; scan128<true>(g0, g1, lane, c0, c1);
        const float gmax = __shfl(c1, 63), btot = __shfl(b1, 63);
        L.bc[128 * d + t0] = b0; L.bc[128 * d + t1] = b1; L.gg[128 * d + t0] = g0; L.gg[128 * d + t1] = g1; L.cm[128 * d + t0] = c0; L.cm[128 * d + t1] = c1;
        L.ee[128 * d + t0] = fast_exp(g0 - gmax); L.ee[128 * d + t1] = fast_exp(g1 - gmax);
        if (lane == 0) { L.sc[d] = btot; L.sc[2 + d] = gmax; }
    }
}
__device__ __forceinline__ void stage_conv(const bf16_t* __restrict__ U, int tokbase, int spos, int ucol, const float* __restrict__ cw, const float* __restrict__ cb, float scale, LAS bf16_t* dst, int tid) {
    const int cg = tid & 15, c0 = ucol + cg * 8, r0 = tid >> 4;
    float w0[8], w1[8], w2[8], bb[8];
#pragma unroll
    for (int e = 0; e < 8; ++e) { w0[e] = cw[c0 + e]; w1[e] = cw[1024 + c0 + e]; w2[e] = cw[2048 + c0 + e]; bb[e] = cb[c0 + e]; }
#pragma unroll
    for (int j = 0; j < 4; ++j) { const int r = r0 + 32 * j, s = spos + r; const bf16_t* up = U + (size_t)(tokbase + r) * NU + c0;
        const u32x4 z = (u32x4){0u, 0u, 0u, 0u};
        const u32x4 xm = s > 0 ? *(const u32x4*)(up - NU) : z, x0 = *(const u32x4*)up, xp = s < SEQ - 1 ? *(const u32x4*)(up + NU) : z;
        float o[8];
#pragma unroll
        for (int e = 0; e < 4; ++e) { const float a0 = bflo(xm[e]), a1 = bfhi(xm[e]), b0 = bflo(x0[e]), b1 = bfhi(x0[e]), c0_ = bflo(xp[e]), c1_ = bfhi(xp[e]);
            float v0 = w0[2 * e] * a0 + w1[2 * e] * b0 + w2[2 * e] * c0_ + bb[2 * e], v1 = w0[2 * e + 1] * a1 + w1[2 * e + 1] * b1 + w2[2 * e + 1] * c1_ + bb[2 * e + 1];
            o[2 * e] = v0 * sigmoid_f(v0) * scale; o[2 * e + 1] = v1 * sigmoid_f(v1) * scale; }
        u32x4 w; w.x = cvt_pk_bf16(o[0], o[1]); w.y = cvt_pk_bf16(o[2], o[3]); w.z = cvt_pk_bf16(o[4], o[5]); w.w = cvt_pk_bf16(o[6], o[7]);
        *(LAS u32x4*)(dst + r * LDP + cg * 8) = w; }
}

__device__ __forceinline__ void mlstm_local(const Args& a, LAS unsigned char* lds, int unit) {
    int tid = threadIdx.x; asm volatile("" : "+v"(tid)); const int lane = tid & 63, wave = __builtin_amdgcn_readfirstlane(tid >> 6);
    unsigned char* ws = a.ws;
    const bf16_t* U = (const bf16_t*)(ws + WS_U); const float* GG = (const float*)(ws + WS_G);
    bf16_t* LOCC = (bf16_t*)(ws + WS_LOCC); float* LOCN = (float*)(ws + WS_LOCN); float* MSC = (float*)(ws + WS_MSC);
    const int c = unit & 31, bh = unit >> 5, h = bh & 3, b = bh >> 2, tokbase = b * SEQ + c * 128;
    LAS bf16_t* Ks = (LAS bf16_t*)lds; LAS bf16_t* Vf = (LAS bf16_t*)(lds + IMG); LAS bf16_t* Vb = (LAS bf16_t*)(lds + 2 * IMG);
    const GateLds L = gate_lds(lds + 4 * IMG);
    { const int t = tid & 127, k = tid >> 7; L.gi[k * 128 + t] = GG[(size_t)(tokbase + t) * 16 + k * 4 + h]; }
    stage_conv(U, tokbase, c * 128, UC_K + h * 128, a.in[6], a.in[7], 0.08838834764831845f, Ks, tid);
    const int cg = tid & 15, r0 = tid >> 4; u32x4 vr[4];
#pragma unroll
    for (int j = 0; j < 4; ++j) vr[j] = *(const u32x4*)(U + (size_t)(tokbase + r0 + 32 * j) * NU + UC_V + h * 128 + cg * 8);
    __syncthreads();
    gate_scans(L, wave, lane);
    __syncthreads();
#pragma unroll
    for (int j = 0; j < 4; ++j) { const int r = r0 + 32 * j; const float ef = L.ee[r], eb = L.ee[128 + r]; u32x4 wf, wb;
#pragma unroll
        for (int e = 0; e < 4; ++e) { const float lo = bflo(vr[j][e]), hi = bfhi(vr[j][e]); wf[e] = cvt_pk_bf16(lo * ef, hi * ef); wb[e] = cvt_pk_bf16(lo * eb, hi * eb); }
        *(LAS u32x4*)(Vf + r * LDP + cg * 8) = wf; *(LAS u32x4*)(Vb + r * LDP + cg * 8) = wb; }
    __syncthreads();
    if (tid < 256) { const int d = tid >> 7, dk = tid & 127; float s = 0.f;
#pragma unroll 8
        for (int t = 0; t < 128; ++t) s += L.ee[128 * d + t] * bf2f(Ks[t * LDP + dk]);
        LOCN[(size_t)(unit * 2 + d) * 128 + dk] = s; }
    if (tid < 2) { MSC[(unit * 2 + tid) * 4 + 0] = L.sc[tid]; MSC[(unit * 2 + tid) * 4 + 1] = L.sc[tid] + L.sc[2 + tid]; }
    const int d = wave >> 2, dvb = 32 * (wave & 3); const LAS bf16_t* Vw = d ? Vb : Vf;
    f32x4 acc[2][8];
#pragma unroll
    for (int i = 0; i < 2; ++i)
#pragma unroll
        for (int j = 0; j < 8; ++j) acc[i][j] = (f32x4){0.f, 0.f, 0.f, 0.f};
#pragma unroll
    for (int ks = 0; ks < 4; ++ks) { s16x4 vl[2], vh[2], kl[8], kh[8];
#pragma unroll
        for (int i = 0; i < 2; ++i) frag_tr_issue(Vw, 32 * ks, dvb + 16 * i, lane, vl[i], vh[i]);
#pragma unroll
        for (int j = 0; j < 8; ++j) frag_tr_issue(Ks, 32 * ks, 16 * j, lane, kl[j], kh[j]);
        LDS_WAIT(); SBAR();
#pragma unroll
        for (int i = 0; i < 2; ++i)
#pragma unroll
            for (int j = 0; j < 8; ++j) acc[i][j] = __builtin_amdgcn_mfma_f32_16x16x32_bf16(PK8(kl[j], kh[j]), PK8(vl[i], vh[i]), acc[i][j], 0, 0, 0); }
    bf16_t* outp = LOCC + (size_t)(unit * 2 + d) * 16384;
#pragma unroll
    for (int i = 0; i < 2; ++i)
#pragma unroll
        for (int j = 0; j < 8; ++j) { u32x2 w; w.x = cvt_pk_bf16(acc[i][j][0], acc[i][j][1]); w.y = cvt_pk_bf16(acc[i][j][2], acc[i][j][3]);
            *(u32x2*)(outp + (dvb + 16 * i + (lane & 15)) * 128 + 16 * j + 4 * (lane >> 4)) = w; }
    __syncthreads();
}

__device__ __forceinline__ void mlstm_scan(const Args& a, int vcu, int G) {
    unsigned char* ws = a.ws; bf16_t* LOCC = (bf16_t*)(ws + WS_LOCC); float* LOCN = (float*)(ws + WS_LOCN); float* MSC = (float*)(ws + WS_MSC);
    const int gt = vcu * 512 + threadIdx.x, NGT = G * 512;
    for (int idx = gt; idx < 64 * 2048; idx += NGT) {
        const int seq = idx >> 11, e8 = idx & 2047, bh = seq >> 1, d = seq & 1;
        float st[8], sn[8]; float m = 0.f;
#pragma unroll
        for (int k = 0; k < 8; ++k) { st[k] = 0.f; sn[k] = 0.f; }
        const bool don = e8 < 16;
#pragma unroll 1
        for (int cb = 0; cb < 32; cb += 8) {
            u32x4 ld[8]; f32x4 n0[8], n1[8];
#pragma unroll
            for (int k = 0; k < 8; ++k) { const int c = d ? 31 - (cb + k) : cb + k; const int un = (bh * 32 + c) * 2 + d;
                ld[k] = *(const u32x4*)(LOCC + (size_t)un * 16384 + e8 * 8);
                if (DBG_MODE == 7) { const unsigned pat = 0x3c003c00u + (unsigned)((e8 * 7 + c) & 63); ld[k] = (u32x4){pat, pat, pat, pat}; }
                if (don) { n0[k] = *(const f32x4*)(LOCN + (size_t)un * 128 + e8 * 8); n1[k] = *(const f32x4*)(LOCN + (size_t)un * 128 + e8 * 8 + 4); } }
#pragma unroll
            for (int k = 0; k < 8; ++k) { const int c = d ? 31 - (cb + k) : cb + k; const int un = (bh * 32 + c) * 2 + d;
                const float bt = MSC[un * 4 + 0], mw = MSC[un * 4 + 1];
                const float mn = fmaxf(bt + m, mw), fa = fast_exp(bt + m - mn), fc = fast_exp(mw - mn);
                u32x4 pv; pv.x = cvt_pk_bf16(st[0], st[1]); pv.y = cvt_pk_bf16(st[2], st[3]); pv.z = cvt_pk_bf16(st[4], st[5]); pv.w = cvt_pk_bf16(st[6], st[7]);
                *(u32x4*)(LOCC + (size_t)un * 16384 + e8 * 8) = pv;
#pragma unroll
                for (int q = 0; q < 4; ++q) { st[2 * q] = fa * st[2 * q] + fc * bflo(ld[k][q]); st[2 * q + 1] = fa * st[2 * q + 1] + fc * bfhi(ld[k][q]); }
                if (don) { *(f32x4*)(LOCN + (size_t)un * 128 + e8 * 8) = (f32x4){sn[0], sn[1], sn[2], sn[3]}; *(f32x4*)(LOCN + (size_t)un * 128 + e8 * 8 + 4) = (f32x4){sn[4], sn[5], sn[6], sn[7]};
#pragma unroll
                    for (int q = 0; q < 4; ++q) { sn[q] = fa * sn[q] + fc * n0[k][q]; sn[4 + q] = fa * sn[4 + q] + fc * n1[k][q]; } }
                if (e8 == 0) MSC[un * 4 + 2] = m;
                m = mn; }
        }
    }
}

__device__ __forceinline__ void mlstm_out(const Args& a, LAS unsigned char* lds, int unit) {
    int tid = threadIdx.x; asm volatile("" : "+v"(tid)); const int lane = tid & 63, wave = __builtin_amdgcn_readfirstlane(tid >> 6);
    unsigned char* ws = a.ws;
    const bf16_t* U = (const bf16_t*)(ws + WS_U); const float* GG = (const float*)(ws + WS_G);
    const bf16_t* CPREV = (const bf16_t*)(ws + WS_LOCC); const float* NPREV = (const float*)(ws + WS_LOCN); const float* MSC = (const float*)(ws + WS_MSC);
    bf16_t* Y = (bf16_t*)(ws + WS_Y);
    const int c = unit & 31, bh = unit >> 5, h = bh & 3, b = bh >> 2, tokbase = b * SEQ + c * 128;
    LAS bf16_t* Qs = (LAS bf16_t*)lds; LAS bf16_t* Ks = (LAS bf16_t*)(lds + IMG); LAS bf16_t* CF = (LAS bf16_t*)(lds + 2 * IMG); LAS bf16_t* CB = (LAS bf16_t*)(lds + 3 * IMG);
    const GateLds L = gate_lds(lds + 4 * IMG);
    LAS float* np = (LAS float*)(lds + 4 * IMG + 6400); LAS float* mp = np + 256;
    { const int t = tid & 127, k = tid >> 7; L.gi[k * 128 + t] = GG[(size_t)(tokbase + t) * 16 + k * 4 + h]; }
    if (tid < 256) np[tid] = NPREV[(size_t)(unit * 2 + (tid >> 7)) * 128 + (tid & 127)];
    if (tid < 2) mp[tid] = MSC[(unit * 2 + tid) * 4 + 2];
    stage_conv(U, tokbase, c * 128, UC_Q + h * 128, a.in[6], a.in[7], 1.0f, Qs, tid);
    stage_conv(U, tokbase, c * 128, UC_K + h * 128, a.in[6], a.in[7], 0.08838834764831845f, Ks, tid);
#pragma unroll
    for (int d = 0; d < 2; ++d) { const bf16_t* src = CPREV + (size_t)(unit * 2 + d) * 16384; LAS bf16_t* dst = d ? CB : CF;
#pragma unroll
        for (int j = 0; j < 4; ++j) { const int v = tid + 512 * j; *(LAS u32x4*)(dst + (v >> 4) * LDP + (v & 15) * 8) = *(const u32x4*)(src + (size_t)v * 8); } }
    __syncthreads();
    gate_scans(L, wave, lane);
    __syncthreads();
    const int t0 = 16 * wave, tl = lane & 15, fq = lane >> 4, t = t0 + tl;
    bf16x8 qf[4];
#pragma unroll
    for (int ks = 0; ks < 4; ++ks) qf[ks] = frag_row(Qs, t, 32 * ks + 8 * fq);
    f32x4 sacc[8], accf[8], accb[8];
#pragma unroll
    for (int j = 0; j < 8; ++j) { sacc[j] = (f32x4){0.f, 0.f, 0.f, 0.f}; accf[j] = sacc[j]; accb[j] = sacc[j]; }
#pragma unroll
    for (int ks = 0; ks < 4; ++ks) {
#pragma unroll
        for (int jh = 0; jh < 2; ++jh) {
#pragma unroll
            for (int jj = 0; jj < 4; ++jj) { const int j = 4 * jh + jj;
                sacc[j] = __builtin_amdgcn_mfma_f32_16x16x32_bf16(frag_row(Ks, 16 * j + tl, 32 * ks + 8 * fq), qf[ks], sacc[j], 0, 0, 0);
                accf[j] = __builtin_amdgcn_mfma_f32_16x16x32_bf16(frag_row(CF, 16 * j + tl, 32 * ks + 8 * fq), qf[ks], accf[j], 0, 0, 0);
                accb[j] = __builtin_amdgcn_mfma_f32_16x16x32_bf16(frag_row(CB, 16 * j + tl, 32 * ks + 8 * fq), qf[ks], accb[j], 0, 0, 0); }
            SBAR(); } }
    float qnf = 0.f, qnb = 0.f;
#pragma unroll
    for (int k = 0; k < 4; ++k) { const bf16x8 qv = frag_row(Qs, t, 32 * fq + 8 * k);
#pragma unroll
        for (int e = 0; e < 8; ++e) { const float q = bf2f((bf16_t)qv[e]); qnf += q * np[32 * fq + 8 * k + e]; qnb += q * np[128 + 32 * fq + 8 * k + e]; } }
    qnf += __shfl_xor(qnf, 16); qnf += __shfl_xor(qnf, 32); qnb += __shfl_xor(qnb, 16); qnb += __shfl_xor(qnb, 32);
    const int cg = tid & 15, r0 = tid >> 4; u32x4 vr[4];
#pragma unroll
    for (int j = 0; j < 4; ++j) vr[j] = *(const u32x4*)(U + (size_t)(tokbase + r0 + 32 * j) * NU + UC_V + h * 128 + cg * 8);
    __syncthreads();
#pragma unroll
    for (int j = 0; j < 4; ++j) *(LAS u32x4*)(CF + (r0 + 32 * j) * LDP + cg * 8) = vr[j];
    const float Mf = fmaxf(mp[0], L.cm[t]), Mb = fmaxf(mp[1], L.cm[128 + t]);
    float rsf = 0.f, rsb = 0.f;
#pragma unroll
    for (int j = 0; j < 8; ++j) { const int s0 = 16 * j + 4 * fq; const f32x4 gf = *(const LAS f32x4*)(L.gg + s0), gb = *(const LAS f32x4*)(L.gg + 128 + s0);
        float pf[4], pb[4];
#pragma unroll
        for (int r = 0; r < 4; ++r) { const int s = s0 + r; const float wf = (s <= t) ? fast_exp(gf[r] - Mf) : 0.f, wb = (s >= t) ? fast_exp(gb[r] - Mb) : 0.f;
            pf[r] = sacc[j][r] * wf; pb[r] = sacc[j][r] * wb; rsf += pf[r]; rsb += pb[r]; }
        u32x2 wf2, wb2; wf2.x = cvt_pk_bf16(pf[0], pf[1]); wf2.y = cvt_pk_bf16(pf[2], pf[3]); wb2.x = cvt_pk_bf16(pb[0], pb[1]); wb2.y = cvt_pk_bf16(pb[2], pb[3]);
        *(LAS u32x2*)(Qs + t * LDP + s0) = wf2; *(LAS u32x2*)(Ks + t * LDP + s0) = wb2; }
    rsf += __shfl_xor(rsf, 16); rsf += __shfl_xor(rsf, 32); rsb += __shfl_xor(rsb, 16); rsb += __shfl_xor(rsb, 32);
    float af = fast_exp(mp[0] - Mf), ab = fast_exp(mp[1] - Mb);
    if (DBG_MODE == 5) { af = 0.f; ab = 0.f; }
#pragma unroll
    for (int j = 0; j < 8; ++j) { accf[j] *= (DBG_MODE == 6 ? 0.f : af); accb[j] *= (DBG_MODE == 6 ? 0.f : ab); }
    __syncthreads();
#pragma unroll
    for (int ks = 0; ks < 4; ++ks) { const bf16x8 pff = frag_row(Qs, t, 32 * ks + 8 * fq), pbf = frag_row(Ks, t, 32 * ks + 8 * fq);
        s16x4 vl[8], vh[8];
#pragma unroll
        for (int j = 0; j < 8; ++j) frag_tr_issue(CF, 32 * ks, 16 * j, lane, vl[j], vh[j]);
        LDS_WAIT(); SBAR();
#pragma unroll
        for (int j = 0; j < 8; ++j) { const bf16x8 vf = PK8(vl[j], vh[j]);
            accf[j] = __builtin_amdgcn_mfma_f32_16x16x32_bf16(vf, pff, accf[j], 0, 0, 0);
            accb[j] = __builtin_amdgcn_mfma_f32_16x16x32_bf16(vf, pbf, accb[j], 0, 0, 0); } }
    const float denf = rsf + af * qnf, denb = rsb + ab * qnb;
    const float invf = 1.0f / fmaxf(fabsf(denf), fast_exp(-(L.bc[t] + Mf))), invb = 1.0f / fmaxf(fabsf(denb), fast_exp(-(L.bc[128 + t] + Mb)));
    float ssq = 0.f;
#pragma unroll
    for (int j = 0; j < 8; ++j) { accf[j] = accf[j] * invf + accb[j] * invb; ssq += (accf[j][0] * accf[j][0] + accf[j][1] * accf[j][1]) + (accf[j][2] * accf[j][2] + accf[j][3] * accf[j][3]); }
    ssq += __shfl_xor(ssq, 16); ssq += __shfl_xor(ssq, 32);
    const float rstd = __builtin_amdgcn_rsqf(ssq * (1.0f / 128.0f) + EPS);
    const float* gn = a.in[8] + h * 128; const size_t tok = (size_t)(tokbase + t);
#pragma unroll
    for (int j = 0; j < 8; ++j) { const int dv = 16 * j + 4 * fq; const f32x4 g4 = *(const f32x4*)(gn + dv); const u32x2 ow = *(const u32x2*)(U + tok * NU + UC_O + h * 128 + dv);
        const float y0 = accf[j][0] * rstd * g4[0] * sigmoid_f(bflo(ow.x)), y1 = accf[j][1] * rstd * g4[1] * sigmoid_f(bfhi(ow.x));
        const float y2 = accf[j][2] * rstd * g4[2] * sigmoid_f(bflo(ow.y)), y3 = accf[j][3] * rstd * g4[3] * sigmoid_f(bfhi(ow.y));
        u32x2 w; w.x = cvt_pk_bf16(y0, y1); w.y = cvt_pk_bf16(y2, y3); if (DBG_MODE == 4) { w.x = 0u; w.y = 0u; }
        *(u32x2*)(Y + tok * DM + 512 + h * 128 + dv) = w; }
    __syncthreads();
}

namespace att {
constexpr int QBLK = 32, KVBLK = 64;
constexpr float SCALE = 0.07216878364870322f;
constexpr float THR = 8.f;
constexpr int LDQ = 768, LDK = 1024, LDR = 64;
constexpr int SHM_V = 16384, SHM_K = 16384, SHM_R = 8192;
constexpr int OFF_V = 0, OFF_K = 2 * SHM_V, OFF_R = OFF_K + 2 * SHM_K, OFF_WS = OFF_R + 2 * SHM_R, OFF_QR = OFF_WS + 2048;
#define KSWZ(row, colB) ((row) * 256 + ((colB) ^ (((row) & 7) << 4)))
#define RSWZ(row, colB) ((row) * 128 + ((colB) ^ (((row) & 7) << 4)))
__device__ __forceinline__ int crow(int r, int hi) { return (r & 3) + 8 * (r >> 2) + 4 * hi; }
__device__ __forceinline__ void partialSM(f32x16& p0, f32x16& p1, float& m_reg, float& mn, float& alpha) {
  constexpr float C = SCALE * 1.4426950408889634f;
  float pmax = p0[0];
#pragma unroll
  for (int r = 1; r < 16; ++r) pmax = fmaxf(pmax, p0[r]);
#pragma unroll
  for (int r = 0; r < 16; ++r) pmax = fmaxf(pmax, p1[r]);
  { auto rr = __builtin_amdgcn_permlane32_swap(__float_as_uint(pmax), __float_as_uint(pmax), false, false);
    pmax = fmaxf(__uint_as_float(rr[0]), __uint_as_float(rr[1])); }
  if (__builtin_expect(__all(pmax - m_reg <= THR / SCALE), 1)) { mn = m_reg; alpha = 1.f; }
  else { mn = fmaxf(m_reg, pmax); alpha = __builtin_amdgcn_exp2f((m_reg - mn) * C); m_reg = mn; }
  const float mnC = -mn * C;
#pragma unroll
  for (int r = 0; r < 16; ++r) p0[r] = fmaf(p0[r], C, mnC);
#pragma unroll
  for (int r = 0; r < 16; ++r) p1[r] = fmaf(p1[r], C, mnC);
#pragma unroll
  for (int r = 0; r < 16; ++r) p0[r] = __builtin_amdgcn_exp2f(p0[r]);
}
__device__ __forceinline__ void finishSM(f32x16& p0, f32x16& p1, float alpha, float& l_reg, bf16x8& pa0, bf16x8& pa1, bf16x8& pa2, bf16x8& pa3) {
#pragma unroll
  for (int r = 0; r < 16; ++r) p1[r] = __builtin_amdgcn_exp2f(p1[r]);
  float ps = 0;
#pragma unroll
  for (int r = 0; r < 16; ++r) ps += p0[r];
#pragma unroll
  for (int r = 0; r < 16; ++r) ps += p1[r];
  { auto rr = __builtin_amdgcn_permlane32_swap(__float_as_uint(ps), __float_as_uint(ps), false, false);
    ps = __uint_as_float(rr[0]) + __uint_as_float(rr[1]); }
  l_reg = l_reg * alpha + ps;
#define PK4(P, BASE, OUT) do { unsigned a0 = cvt_pk_bf16(P[BASE + 0], P[BASE + 1]), a1 = cvt_pk_bf16(P[BASE + 2], P[BASE + 3]);   \
    unsigned b0 = cvt_pk_bf16(P[BASE + 4], P[BASE + 5]), b1 = cvt_pk_bf16(P[BASE + 6], P[BASE + 7]);                              \
    auto r0 = __builtin_amdgcn_permlane32_swap(a0, b0, false, false); auto r1 = __builtin_amdgcn_permlane32_swap(a1, b1, false, false); \
    u32x4 w = {r0[0], r1[0], r0[1], r1[1]}; OUT = *reinterpret_cast<bf16x8*>(&w); } while (0)
  PK4(p0, 0, pa0); PK4(p0, 8, pa1); PK4(p1, 0, pa2); PK4(p1, 8, pa3);
#undef PK4
}
__device__ __forceinline__ void qkt(f32x16& p0, f32x16& p1, const LAS char* Ks, const LAS char* Rs, const bf16x8* qr, const LAS char* Qrs, int r32, int hi) {
  p0 = f32x16{}; p1 = f32x16{};
#pragma unroll
  for (int d0 = 0; d0 < 8; ++d0) { const int cb = (d0 * 16 + hi * 8) * 2;
    const bf16x8 b0 = *reinterpret_cast<const LAS bf16x8*>(Ks + KSWZ(r32, cb));
    const bf16x8 b1 = *reinterpret_cast<const LAS bf16x8*>(Ks + KSWZ(32 + r32, cb));
    p0 = __builtin_amdgcn_mfma_f32_32x32x16_bf16(b0, qr[d0], p0, 0, 0, 0);
    p1 = __builtin_amdgcn_mfma_f32_32x32x16_bf16(b1, qr[d0], p1, 0, 0, 0); }
#pragma unroll
  for (int d0 = 0; d0 < 4; ++d0) { const int cb = (d0 * 16 + hi * 8) * 2;
    const bf16x8 b0 = *reinterpret_cast<const LAS bf16x8*>(Rs + RSWZ(r32, cb));
    const bf16x8 b1 = *reinterpret_cast<const LAS bf16x8*>(Rs + RSWZ(32 + r32, cb));
    const bf16x8 qv = *reinterpret_cast<const LAS bf16x8*>(Qrs + RSWZ(r32, cb));
    p0 = __builtin_amdgcn_mfma_f32_32x32x16_bf16(b0, qv, p0, 0, 0, 0);
    p1 = __builtin_amdgcn_mfma_f32_32x32x16_bf16(b1, qv, p1, 0, 0, 0); }
}
__device__ __forceinline__ int v_st(int k, int c) { const int kk = (k & ~0xC) | ((k & 4) << 1) | ((k & 8) >> 1); return ((kk >> 3) * 4 + (c >> 5)) * 512 + ((kk & 7) * 32 + (c & 31)) * 2; }
__device__ __forceinline__ int v_rd_base(int lane) { return ((lane & 3) << 3) | (((lane >> 2) & 3) << 6) | (((lane >> 4) & 1) << 5) | (((lane >> 5) & 1) << 8); }
constexpr int v_rd_off(int d0, int ks, int half) { return d0 * 512 + ks * 4096 + half * 2048; }
template <int OFF> __device__ __forceinline__ s16x4 tr_read(int vb) {
  s16x4 r; asm volatile("ds_read_b64_tr_b16 %0, %1 offset:%2" : "=&v"(r) : "v"(vb), "i"(OFF) : "memory"); return r;
}
template <int D0> __device__ __forceinline__ void pv_one(f32x16& od, int vb, bf16x8 pa0, bf16x8 pa1, bf16x8 pa2, bf16x8 pa3) {
  const s16x4 l0 = tr_read<v_rd_off(D0, 0, 0)>(vb), h0 = tr_read<v_rd_off(D0, 0, 1)>(vb), l1 = tr_read<v_rd_off(D0, 1, 0)>(vb), h1 = tr_read<v_rd_off(D0, 1, 1)>(vb);
  const s16x4 l2 = tr_read<v_rd_off(D0, 2, 0)>(vb), h2 = tr_read<v_rd_off(D0, 2, 1)>(vb), l3 = tr_read<v_rd_off(D0, 3, 0)>(vb), h3 = tr_read<v_rd_off(D0, 3, 1)>(vb);
  asm volatile("s_waitcnt lgkmcnt(0)" ::: "memory"); SBAR();
  od = __builtin_amdgcn_mfma_f32_32x32x16_bf16(pa0, PK8(l0, h0), od, 0, 0, 0);
  od = __builtin_amdgcn_mfma_f32_32x32x16_bf16(pa1, PK8(l1, h1), od, 0, 0, 0);
  od = __builtin_amdgcn_mfma_f32_32x32x16_bf16(pa2, PK8(l2, h2), od, 0, 0, 0);
  od = __builtin_amdgcn_mfma_f32_32x32x16_bf16(pa3, PK8(l3, h3), od, 0, 0, 0);
}
__device__ __forceinline__ void pv_d0(f32x16* o, int vb, bf16x8 pa0, bf16x8 pa1, bf16x8 pa2, bf16x8 pa3) {
  pv_one<0>(o[0], vb, pa0, pa1, pa2, pa3); pv_one<1>(o[1], vb, pa0, pa1, pa2, pa3); pv_one<2>(o[2], vb, pa0, pa1, pa2, pa3); pv_one<3>(o[3], vb, pa0, pa1, pa2, pa3);
}
__device__ __forceinline__ void attn_unit(const bf16_t* __restrict__ Qn, const bf16_t* __restrict__ Qr, const bf16_t* __restrict__ Kh, const bf16_t* __restrict__ Vh, const bf16_t* __restrict__ Rh,
                                          bf16_t* __restrict__ Ob, float* __restrict__ ssq, int seq, LAS unsigned char* lds) {
  int tid = threadIdx.x; asm volatile("" : "+v"(tid)); const int wid = tid >> 6, lane = tid & 63, r32 = lane & 31, hi = lane >> 5;
  LAS char* V_lds = (LAS char*)lds + OFF_V; LAS char* K_lds = (LAS char*)lds + OFF_K; LAS char* R_lds = (LAS char*)lds + OFF_R;
  LAS float* wsl = (LAS float*)(lds + OFF_WS) + wid * 64; LAS float* li_l = wsl; LAS float* al_l = wsl + 32;
  float m_reg = -1e30f, l_reg = 0; f32x16 o[4] = {}; bf16x8 qr[8];
  LAS char* Qrs = (LAS char*)lds + OFF_QR + wid * 4096;
  { const bf16_t* Qw = Qn + (size_t)(wid * QBLK + r32) * LDQ + hi * 8; const bf16_t* Qv = Qr + (size_t)(wid * QBLK + r32) * LDQ + hi * 8;
#pragma unroll
    for (int d0 = 0; d0 < 8; ++d0) qr[d0] = *reinterpret_cast<const bf16x8*>(Qw + d0 * 16);
#pragma unroll
    for (int d0 = 0; d0 < 4; ++d0) *(LAS bf16x8*)(Qrs + RSWZ(r32, (d0 * 16 + hi * 8) * 2)) = *reinterpret_cast<const bf16x8*>(Qv + d0 * 16); }
  const int sr = tid >> 4, sc = (tid & 15) * 8, vst0 = v_st(sr, sc), vst1 = v_st(32 + sr, sc);
  const int rr = tid >> 3, rc = (tid & 7) * 8;
  const int vb0 = (int)lds_addr(V_lds) + v_rd_base(lane);
  bf16x8 vs0, vs1, ks0, ks1, rs0;
#define SLOAD(k0) do { vs0 = *reinterpret_cast<const bf16x8*>(&Vh[(size_t)((k0) + sr) * LDK + sc]); vs1 = *reinterpret_cast<const bf16x8*>(&Vh[(size_t)((k0) + 32 + sr) * LDK + sc]); \
    ks0 = *reinterpret_cast<const bf16x8*>(&Kh[(size_t)((k0) + sr) * LDK + sc]); ks1 = *reinterpret_cast<const bf16x8*>(&Kh[(size_t)((k0) + 32 + sr) * LDK + sc]); \
    rs0 = *reinterpret_cast<const bf16x8*>(&Rh[(size_t)((k0) + rr) * LDR + rc]); } while (0)
#define SWRITE(b) do { *(LAS bf16x8*)(V_lds + (b) * SHM_V + vst0) = vs0; *(LAS bf16x8*)(V_lds + (b) * SHM_V + vst1) = vs1; const int kc = sc * 2;               \
    *(LAS bf16x8*)(K_lds + (b) * SHM_K + KSWZ(sr, kc)) = ks0; *(LAS bf16x8*)(K_lds + (b) * SHM_K + KSWZ(32 + sr, kc)) = ks1;                       \
    *(LAS bf16x8*)(R_lds + (b) * SHM_R + RSWZ(rr, rc * 2)) = rs0; } while (0)
#define RESC(a) do { if (__any((a) < 1.f)) { if (hi == 0) al_l[r32] = (a); asm volatile("s_waitcnt lgkmcnt(0)" ::: "memory"); \
    _Pragma("unroll") for (int d = 0; d < 4; ++d) _Pragma("unroll") for (int r = 0; r < 16; ++r) o[d][r] *= al_l[crow(r, hi)]; } } while (0)
  f32x16 pA0, pA1, pB0, pB1; float mnA, mnB, alA, alB; bf16x8 pa0, pa1, pa2, pa3; const int NT = seq / KVBLK;
  SLOAD(0); asm volatile("s_waitcnt vmcnt(0)" ::: "memory"); SWRITE(0); __syncthreads();
  qkt(pA0, pA1, K_lds, R_lds, qr, Qrs, r32, hi); partialSM(pA0, pA1, m_reg, mnA, alA);
  SLOAD(KVBLK);
  asm volatile("s_waitcnt vmcnt(0)" ::: "memory"); SWRITE(1); __syncthreads();
  for (int j = 1; j + 1 < NT; j += 2) {
    SBAR(); qkt(pB0, pB1, K_lds + SHM_K, R_lds + SHM_R, qr, Qrs, r32, hi);
    finishSM(pA0, pA1, alA, l_reg, pa0, pa1, pa2, pa3); SBAR();
    SLOAD((j + 1) * KVBLK); SBAR();
    pv_d0(o, vb0, pa0, pa1, pa2, pa3); partialSM(pB0, pB1, m_reg, mnB, alB);
    __syncthreads(); asm volatile("s_waitcnt vmcnt(0)" ::: "memory"); SWRITE(0);
    RESC(alB); __syncthreads();
    SBAR(); qkt(pA0, pA1, K_lds, R_lds, qr, Qrs, r32, hi);
    finishSM(pB0, pB1, alB, l_reg, pa0, pa1, pa2, pa3); SBAR();
    SLOAD((j + 2) * KVBLK); SBAR();
    pv_d0(o, vb0 + SHM_V, pa0, pa1, pa2, pa3); partialSM(pA0, pA1, m_reg, mnA, alA);
    __syncthreads(); asm volatile("s_waitcnt vmcnt(0)" ::: "memory"); SWRITE(1);
    RESC(alA); __syncthreads();
  }
  SBAR(); qkt(pB0, pB1, K_lds + SHM_K, R_lds + SHM_R, qr, Qrs, r32, hi);
  finishSM(pA0, pA1, alA, l_reg, pa0, pa1, pa2, pa3); SBAR();
  pv_d0(o, vb0, pa0, pa1, pa2, pa3); partialSM(pB0, pB1, m_reg, mnB, alB);
  __syncthreads(); RESC(alB);
  finishSM(pB0, pB1, alB, l_reg, pa0, pa1, pa2, pa3); SBAR();
  pv_d0(o, vb0 + SHM_V, pa0, pa1, pa2, pa3);
  if (hi == 0) li_l[r32] = l_reg; asm volatile("s_waitcnt lgkmcnt(0)" ::: "memory");
  bf16_t* Ow = Ob + (size_t)(wid * QBLK) * DM; float* sq = ssq + wid * QBLK;
#pragma unroll
  for (int r = 0; r < 16; ++r) { const int orow = crow(r, hi); const float rl = __builtin_amdgcn_rcpf(li_l[orow]); float q = 0.f;
#pragma unroll
    for (int d0 = 0; d0 < 4; ++d0) { const float v = o[d0][r] * rl; q += v * v; Ow[(size_t)orow * DM + d0 * 32 + r32] = (DBG_MODE == 3 || DBG_MODE >= 5) ? (bf16_t)0 : (bf16_t)(cvt_pk_bf16(v, v) & 0xffffu); }
    q += __shfl_xor(q, 1); q += __shfl_xor(q, 2); q += __shfl_xor(q, 4); q += __shfl_xor(q, 8); q += __shfl_xor(q, 16);
    if (r32 == r) atomicAdd(sq + orow, q); }
  __syncthreads();
#undef SLOAD
#undef SWRITE
#undef RESC
}
}

constexpr int RW_PITCH = 1032;
__device__ __forceinline__ void p7_router(const Args& a, LAS unsigned char* lds, int vcu, int G) {
    const int tid = threadIdx.x, lane = tid & 63, wave = __builtin_amdgcn_readfirstlane(tid >> 6);
    unsigned char* ws = a.ws;
    const float* H1 = (const float*)(ws + WS_H1); const float* ssq1 = (const float*)(ws + CTLB_SSQ1); bf16_t* XN2 = (bf16_t*)(ws + WS_XN);
    float* GATEW = (float*)(ws + WS_GATEW); int* LIST = (int*)(ws + WS_LIST); unsigned* gcount = (unsigned*)(ws + WS_CTL) + CW_CNT;
    const float* gn = a.in[15]; const float* Wr = a.in[16]; const float* br = a.in[17];
    LAS bf16_t* Wh = (LAS bf16_t*)lds; LAS bf16_t* Wl = Wh + 32 * RW_PITCH;
    LAS float* lg = (LAS float*)(lds + 132096) + wave * 16 * 33;
    LAS int* lcount = (LAS int*)(lds + 132096 + 8 * 16 * 33 * 4);
    LAS int* lbase = lcount + 32; LAS int* lent = lbase + 32;
    for (int idx = tid; idx < 32 * 1024; idx += 512) { const int e = idx & 31, k = idx >> 5; const float w = Wr[idx] * gn[k];
        const unsigned hb = cvt_pk_bf16(w, w) & 0xffffu; const float wl = w - __uint_as_float(hb << 16);
        Wh[e * RW_PITCH + k] = (bf16_t)hb; Wl[e * RW_PITCH + k] = (bf16_t)(cvt_pk_bf16(wl, wl) & 0xffffu); }
    if (tid < 32) lcount[tid] = 0;
    __syncthreads();
    const int fr = lane & 15, fq = lane >> 4;
    for (int bi = vcu; bi < NTOK / 128; bi += G) {
        const int tok0 = bi * 128 + wave * 16, tok = tok0 + fr;
        const float rstd = __builtin_amdgcn_rsqf(ssq1[tok] * (1.0f / DM) + EPS);
        f32x4 acc0 = {0.f, 0.f, 0.f, 0.f}, acc1 = acc0;
        const float* xr = H1 + (size_t)tok * DM + 8 * fq;
#pragma unroll 2
        for (int ks = 0; ks < 32; ++ks) {
            const f32x4 x0 = *(const f32x4*)(xr + 32 * ks), x1 = *(const f32x4*)(xr + 32 * ks + 4);
            const f32x4 g0 = *(const f32x4*)(gn + 32 * ks + 8 * fq), g1 = *(const f32x4*)(gn + 32 * ks + 8 * fq + 4);
            u32x4 hw, lw, nw; float xs[8] = {x0[0], x0[1], x0[2], x0[3], x1[0], x1[1], x1[2], x1[3]}; float gs[8] = {g0[0], g0[1], g0[2], g0[3], g1[0], g1[1], g1[2], g1[3]};
#pragma unroll
            for (int q = 0; q < 4; ++q) { const unsigned h = cvt_pk_bf16(xs[2 * q], xs[2 * q + 1]); hw[q] = h;
                lw[q] = cvt_pk_bf16(xs[2 * q] - bflo(h), xs[2 * q + 1] - bfhi(h));
                nw[q] = cvt_pk_bf16(xs[2 * q] * rstd * gs[2 * q], xs[2 * q + 1] * rstd * gs[2 * q + 1]); }
            *(u32x4*)(XN2 + (size_t)tok * DM + 32 * ks + 8 * fq) = nw;
            const bf16x8 xh = *reinterpret_cast<bf16x8*>(&hw), xl = *reinterpret_cast<bf16x8*>(&lw);
            const bf16x8 wh0 = *(const LAS bf16x8*)(Wh + fr * RW_PITCH + 32 * ks + 8 * fq), wh1 = *(const LAS bf16x8*)(Wh + (16 + fr) * RW_PITCH + 32 * ks + 8 * fq);
            const bf16x8 wl0 = *(const LAS bf16x8*)(Wl + fr * RW_PITCH + 32 * ks + 8 * fq), wl1 = *(const LAS bf16x8*)(Wl + (16 + fr) * RW_PITCH + 32 * ks + 8 * fq);
            acc0 = __builtin_amdgcn_mfma_f32_16x16x32_bf16(xh, wh0, acc0, 0, 0, 0); acc0 = __builtin_amdgcn_mfma_f32_16x16x32_bf16(xl, wh0, acc0, 0, 0, 0); acc0 = __builtin_amdgcn_mfma_f32_16x16x32_bf16(xh, wl0, acc0, 0, 0, 0);
            acc1 = __builtin_amdgcn_mfma_f32_16x16x32_bf16(xh, wh1, acc1, 0, 0, 0); acc1 = __builtin_amdgcn_mfma_f32_16x16x32_bf16(xl, wh1, acc1, 0, 0, 0); acc1 = __builtin_amdgcn_mfma_f32_16x16x32_bf16(xh, wl1, acc1, 0, 0, 0);
        }
#pragma unroll
        for (int r = 0; r < 4; ++r) { lg[(4 * fq + r) * 33 + fr] = acc0[r]; lg[(4 * fq + r) * 33 + 16 + fr] = acc1[r]; }
        LDS_WAIT(); asm volatile("" ::: "memory");
        if (lane < 16) { const int tk = tok0 + lane; const float rs = __builtin_amdgcn_rsqf(ssq1[tk] * (1.0f / DM) + EPS);
            float v[32];
#pragma unroll
            for (int e = 0; e < 32; ++e) v[e] = lg[lane * 33 + e] * rs + br[e];
            int bi4[4]; float bv4[4];
#pragma unroll
            for (int k = 0; k < 4; ++k) { float bv = -INFINITY; int be = 0;
#pragma unroll
                for (int e = 0; e < 32; ++e) { const bool tk_ = v[e] > bv; bv = tk_ ? v[e] : bv; be = tk_ ? e : be; }
                bi4[k] = be; bv4[k] = bv;
#pragma unroll
                for (int e = 0; e < 32; ++e) v[e] = (e == be) ? -INFINITY : v[e]; }
            const float e1 = __expf(bv4[1] - bv4[0]), e2 = __expf(bv4[2] - bv4[0]), e3 = __expf(bv4[3] - bv4[0]); const float inv = 1.0f / (1.0f + e1 + e2 + e3);
            const float gw[4] = {inv, e1 * inv, e2 * inv, e3 * inv};
            *(f32x4*)(GATEW + (size_t)tk * 4) = (f32x4){gw[0], gw[1], gw[2], gw[3]};
#pragma unroll
            for (int k = 0; k < 4; ++k) { const int pos = atomicAdd((int*)(lcount + bi4[k]), 1); const int n = (wave * 16 + lane) * 4 + k; lent[n] = (bi4[k] << 20) | pos; } }
        __syncthreads();
        if (tid < 32) { lbase[tid] = (int)__hip_atomic_fetch_add(gcount + 64 * tid, (unsigned)lcount[tid], __ATOMIC_RELAXED, __HIP_MEMORY_SCOPE_AGENT); }
        __syncthreads();
        { const int en = lent[tid], e = en >> 20, pos = en & 0xfffff; LIST[(size_t)e * NTOK + lbase[e] + pos] = bi * 512 + tid; }
        __syncthreads();
        if (tid < 32) lcount[tid] = 0;
        __syncthreads();
    }
}

__device__ __forceinline__ int moe_table(const Args& a, LAS unsigned char* lds) {
    LAS int* tab = (LAS int*)(lds + LDS_TAB); const unsigned* gcount = (const unsigned*)(a.ws + WS_CTL) + CW_CNT;
    if (threadIdx.x == 0) { int T = 0;
        for (int e = 0; e < NEXP; ++e) { const int cnt = (int)__hip_atomic_load(gcount + 64 * e, __ATOMIC_RELAXED, __HIP_MEMORY_SCOPE_AGENT);
            for (int r0 = 0; r0 < cnt; r0 += 256) { const int v = cnt - r0 < 256 ? cnt - r0 : 256; tab[2 * T] = e | (v << 8); tab[2 * T + 1] = r0; ++T; } }
        tab[2 * MAXTILES] = T; }
    __syncthreads();
    return tab[2 * MAXTILES];
}

__device__ __forceinline__ void p10_combine(const Args& a, int vcu, int G) {
    const int tid = threadIdx.x, lane = tid & 63, wave = __builtin_amdgcn_readfirstlane(tid >> 6); unsigned char* ws = a.ws; const int gw = vcu * 8 + wave, NGW = G * 8;
    float* H1 = (float*)(ws + WS_H1); const bf16_t* YS = (const bf16_t*)(ws + WS_YS); bf16_t* XN3 = (bf16_t*)(ws + WS_XN3); const float* g = a.in[22];
    f32x4 gv[4];
#pragma unroll
    for (int j = 0; j < 4; ++j) gv[j] = *(const f32x4*)(g + 4 * lane + 256 * j);
    for (int m = gw; m < NTOK; m += NGW) { f32x4* hr = (f32x4*)(H1 + (size_t)m * DM) + lane; f32x4 v[4]; float s = 0.f;
#pragma unroll
        for (int j = 0; j < 4; ++j) { v[j] = hr[64 * j];
#pragma unroll
            for (int k = 0; k < (DBG_MODE >= 1 ? 0 : 4); ++k) { const u32x2 w = *((const u32x2*)(YS + ((size_t)m * 4 + k) * DM) + lane + 64 * j); v[j][0] += bflo(w.x); v[j][1] += bfhi(w.x); v[j][2] += bflo(w.y); v[j][3] += bfhi(w.y); }
            hr[64 * j] = v[j]; s += (v[j][0] * v[j][0] + v[j][1] * v[j][1]) + (v[j][2] * v[j][2] + v[j][3] * v[j][3]); }
        const float rstd = __builtin_amdgcn_rsqf(wave_sum(s) * (1.0f / DM) + EPS);
        u32x2* o8 = (u32x2*)(XN3 + (size_t)m * DM) + lane;
#pragma unroll
        for (int j = 0; j < 4; ++j) { u32x2 o; o.x = cvt_pk_bf16(v[j][0] * rstd * gv[j][0], v[j][1] * rstd * gv[j][1]); o.y = cvt_pk_bf16(v[j][2] * rstd * gv[j][2], v[j][3] * rstd * gv[j][3]); o8[64 * j] = o; } }
}
__device__ __forceinline__ void p12_final(const Args& a, int vcu, int G) {
    const int tid = threadIdx.x, lane = tid & 63, wave = __builtin_amdgcn_readfirstlane(tid >> 6); unsigned char* ws = a.ws; const int gw = vcu * 8 + wave, NGW = G * 8;
    const float* ssq3 = (const float*)(ws + CTLB_SSQ3); const float* g = a.in[25];
    f32x4 gv[4];
#pragma unroll
    for (int j = 0; j < 4; ++j) gv[j] = *(const f32x4*)(g + 4 * lane + 256 * j);
    for (int m = gw; m < NTOK; m += NGW) { f32x4* hr = (f32x4*)(a.out + (size_t)m * DM) + lane; const float rstd = __builtin_amdgcn_rsqf(ssq3[m] * (1.0f / DM) + EPS);
#pragma unroll
        for (int j = 0; j < 4; ++j) { f32x4 v = hr[64 * j]; v = v * rstd * gv[j]; hr[64 * j] = v; } }
}

__global__ void __launch_bounds__(512, 2) fwd_kernel(Args a) {
    extern __shared__ __attribute__((aligned(16))) unsigned char lds_raw[];
    LAS unsigned char* lds = (LAS unsigned char*)lds_raw;
    const int tid = threadIdx.x;
    const int G = gridDim.x; const int bx = blockIdx.x; const int vcu = (G % 8 == 0) ? (bx % 8) * (G / 8) + bx / 8 : bx;
    unsigned char* ws = a.ws;
    volatile LAS unsigned* MISC = (volatile LAS unsigned*)(lds + LDS_MISC);
    if (tid < 64) MISC[tid] = 0u;
    __syncthreads();
    unsigned* ctl = (unsigned*)(ws + WS_CTL);
    XcdBarrier bar; bar.bar = ctl + CW_BAR; bar.x = 0; bar.st = nullptr;
    if (MK_ONE_LAUNCH) bar = xcd_barrier_post(ctl + CW_BAR, MISC + 8);
    const int lo = a.ph_lo, hi = a.ph_hi;
#ifndef PHASE_MASK
#define PHASE_MASK 0x1fff
#endif
#define IN(k) (((PHASE_MASK >> (k)) & 1) && lo <= (k) && (k) < hi)
#define SEAM(k) do { if (IN(k) && IN((k) + 1)) xcd_barrier(bar); } while (0)

    bf16_t* U = (bf16_t*)(ws + WS_U); bf16_t* XN = (bf16_t*)(ws + WS_XN); bf16_t* Q = (bf16_t*)(ws + WS_Q); bf16_t* KV = (bf16_t*)(ws + WS_KV);
    bf16_t* Y = (bf16_t*)(ws + WS_Y); float* H1 = (float*)(ws + WS_H1);

    if (IN(0)) { p0_prologue(a, lds, vcu, G); } SEAM(0);

    if (IN(1)) {
        ProbBf16<false> p; p.Abase = (const char*)XN; p.lda = DM; p.Bt = (const bf16_t*)(ws + WS_WIN); p.ldb = DM; p.K = DM; p.tmid = 0; p.S.init(128, 10, G, bx);
        p.O = U; p.ldc = NU; p.rope_pn = -1; p.cs = nullptr;
        pg8::gemm_phase(lds, p);
    } SEAM(1);

    if (IN(2)) { p2_tail(a, vcu, G); } SEAM(2);

    if (IN(3)) {
        { ProbBf16<true> p; p.Abase = (const char*)(U + UC_CQ); p.lda = NU; p.Bt = (const bf16_t*)(ws + WS_WQ); p.ldb = 256; p.K = 256; p.tmid = 0; p.S.init(128, 3, G, bx);
          p.O = Q; p.ldc = 768; p.rope_pn = 2; p.cs = (const float*)(ws + WS_CS); pg8::gemm_phase(lds, p); }
        { ProbBf16<false> p; p.Abase = (const char*)(U + UC_CKV); p.lda = NU; p.Bt = (const bf16_t*)(ws + WS_WKV); p.ldb = 256; p.K = 256; p.tmid = 0; p.S.init(128, 4, G, bx);
          p.O = KV; p.ldc = 1024; p.rope_pn = -1; p.cs = nullptr; pg8::gemm_phase(lds, p); }
        { ProbBf16<false> p; p.Abase = (const char*)(ws + WS_PB); p.lda = 256; p.Bt = (const bf16_t*)(ws + WS_WPP); p.ldb = 256; p.K = 256; p.tmid = 0; p.S.init(128, 4, G, bx);
          p.O = (bf16_t*)(ws + WS_PP); p.ldc = 1024; p.rope_pn = -1; p.cs = nullptr; pg8::gemm_phase(lds, p); }
#ifndef NO_MLOC
        for (int u = vcu; u < 1024; u += G) mlstm_local(a, lds, u);
#endif
    } SEAM(3);

    if (IN(4)) { mlstm_scan(a, vcu, G); } SEAM(4);

    if (IN(5)) {
#ifndef NO_ATT
        for (int u = vcu; u < 512; u += G) {
            const int qb = u & 15, bh = u >> 4, h = bh & 3, b = bh >> 2; const size_t t0 = (size_t)b * SEQ;
            att::attn_unit(Q + (t0 + qb * 256) * 768 + h * 128, Q + (t0 + qb * 256) * 768 + 512 + h * 64, KV + t0 * 1024 + h * 128, KV + t0 * 1024 + 512 + h * 128,
                           (const bf16_t*)(ws + WS_KPE) + t0 * 64, Y + (t0 + qb * 256) * DM + h * 128, (float*)(ws + CTLB_SSQO) + t0 + qb * 256, SEQ, lds);
        }
#endif
#ifndef NO_MOUT
        for (int u = vcu; u < 1024; u += G) mlstm_out(a, lds, u);
#endif
    } SEAM(5);

    if (IN(6)) {
        ProbWout p; p.Abase = (const char*)Y; p.lda = DM; p.Bt = (const bf16_t*)(ws + WS_WOUT); p.ldb = DM; p.K = DM; p.tmid = 8; p.S.init(128, 4, G, bx);
        p.x = a.in[0]; p.H1 = H1; p.ssqo = (const float*)(ws + CTLB_SSQO); p.ssq1 = (float*)(ws + CTLB_SSQ1);
        pg8::gemm_phase(lds, p);
    } SEAM(6);

    if (IN(7)) { p7_router(a, lds, vcu, G); } SEAM(7);

    if (IN(8)) {
        const int T = moe_table(a, lds);
        ProbMoe1 p; p.Abase = (const char*)XN; p.Wgu = (const bf16_t*)(ws + WS_WGU); p.ldb = DM; p.K = DM; p.tmid = 0;
        p.S.tab = (const LAS int*)(lds + LDS_TAB); p.S.T = T; p.S.nN = 8; p.S.G = G; p.S.c = bx;
        p.list = (const int*)(ws + WS_LIST); p.bgu = a.in[19]; p.HMID = (bf16_t*)(ws + WS_HMID);
        pg8::gemm_phase(lds, p);
    } SEAM(8);

    if (IN(9)) {
        const int T = moe_table(a, lds);
        ProbMoe2 p; p.Abase = (const char*)(ws + WS_HMID); p.Wdn = (const bf16_t*)(ws + WS_WDN); p.ldb = DM; p.K = DM; p.tmid = 0;
        p.S.tab = (const LAS int*)(lds + LDS_TAB); p.S.T = T; p.S.nN = 4; p.S.G = G; p.S.c = bx;
        p.list = (const int*)(ws + WS_LIST); p.bdn = a.in[21]; p.gatew = (const float*)(ws + WS_GATEW); p.YS = (bf16_t*)(ws + WS_YS);
        pg8::gemm_phase(lds, p);
    } SEAM(9);

    if (IN(10)) { p10_combine(a, vcu, G); } SEAM(10);

    if (IN(11)) {
        ProbPle p; p.Abase = (const char*)(ws + WS_XN3); p.lda = DM; p.Bt = (const bf16_t*)(ws + WS_WPG); p.ldb = DM; p.K = DM; p.tmid = 0; p.S.init(128, 4, G, bx);
        p.H2 = H1; p.PP = (const bf16_t*)(ws + WS_PP); p.out = a.out; p.ssq3 = (float*)(ws + CTLB_SSQ3);
        pg8::gemm_phase(lds, p);
    } SEAM(11);

    if (IN(12)) { p12_final(a, vcu, G); }
#undef IN
#undef SEAM
}

extern "C" void kernel_launch(void* const* d_in, const int* in_sizes, int n_in, void* d_out, int out_size, void* d_ws, size_t ws_size, hipStream_t stream) {
    static int grid = 0;
    if (grid == 0) {
        if (n_in != 26 || in_sizes[0] != NTOK * DM || out_size != NTOK * DM || ws_size < WS_END) {
            fprintf(stderr, "kernel_launch: unexpected shapes: n_in %d in0 %d out %d ws %zu (need %zu)\n", n_in, n_in > 0 ? in_sizes[0] : -1, out_size, ws_size, (size_t)WS_END); grid = -1; return; }
        int dev = 0, cus = 0, per_cu = 0;
        if (hipGetDevice(&dev) != hipSuccess || hipDeviceGetAttribute(&cus, hipDeviceAttributeMultiprocessorCount, dev) != hipSuccess) { grid = -1; return; }
        if (hipFuncSetAttribute((const void*)fwd_kernel, hipFuncAttributeMaxDynamicSharedMemorySize, LDS_BYTES) != hipSuccess) { fprintf(stderr, "kernel_launch: hipFuncSetAttribute failed\n"); grid = -1; return; }
        if (hipOccupancyMaxActiveBlocksPerMultiprocessor(&per_cu, (const void*)fwd_kernel, 512, LDS_BYTES) != hipSuccess || per_cu < 1) { fprintf(stderr, "kernel_launch: occupancy query says %d\n", per_cu); }
        (void)hipGetLastError();
        grid = cus - (cus % 8);
        if (grid <= 0) grid = 8;
    }
    if (grid < 0) return;
    (void)hipMemsetAsync((char*)d_ws + WS_CTL, 0, CTL_ZERO_BYTES, stream);
    Args a{};
    for (int i = 0; i < 26; ++i) a.in[i] = (const float*)d_in[i];
    a.out = (float*)d_out; a.ws = (unsigned char*)d_ws;
#if MK_ONE_LAUNCH
    a.ph_lo = 0; a.ph_hi = NPHASE;
    hipLaunchKernelGGL(fwd_kernel, dim3(grid), dim3(512), LDS_BYTES, stream, a);
#else
    for (int ph = 0; ph < NPHASE; ++ph) { a.ph_lo = ph; a.ph_hi = ph + 1; hipLaunchKernelGGL(fwd_kernel, dim3(grid), dim3(512), LDS_BYTES, stream, a); }
#endif
    const hipError_t le = hipPeekAtLastError();
    if (le != hipSuccess) fprintf(stderr, "kernel_launch: launch failed: %s\n", hipGetErrorName(le));
}
```

```cpp
#include <hip/hip_runtime.h>
#include <cstdio>
#include <cstdint>

#ifndef PROBE_DUP
#define PROBE_DUP 0
#endif
#ifndef DBG_MODE
#define DBG_MODE 0
#endif
#ifndef MK_ONE_LAUNCH
#define MK_ONE_LAUNCH 1
#endif

#define LAS __attribute__((address_space(3)))
#define GAS __attribute__((address_space(1)))
typedef unsigned short bf16_t;
typedef short bf16x8 __attribute__((ext_vector_type(8)));
typedef short s16x4 __attribute__((ext_vector_type(4)));
typedef float f32x2 __attribute__((ext_vector_type(2)));
typedef float f32x4 __attribute__((ext_vector_type(4)));
typedef float f32x16 __attribute__((ext_vector_type(16)));
typedef unsigned u32x2 __attribute__((ext_vector_type(2)));
typedef unsigned u32x4 __attribute__((ext_vector_type(4)));
typedef long i64x2 __attribute__((ext_vector_type(2)));

constexpr int NTOK = 32768, DM = 1024, SEQ = 4096, NBATCH = 8;
constexpr int NU = 2560;
constexpr int UC_Q = 0, UC_K = 512, UC_V = 1024, UC_O = 1536, UC_CQ = 2048, UC_CKV = 2304, UC_KR = 2432, UC_G = 2496;
constexpr int NEXP = 32, TOPK = 4, NSLOT = NTOK * TOPK;
constexpr int MAXTILES = 544;
constexpr float EPS = 1e-6f;
constexpr int NPHASE = 13;

constexpr size_t MiB = 1u << 20;
constexpr size_t WS_CTL = 0, CTL_ZERO_BYTES = 1 * MiB;
constexpr size_t CTLB_SSQO = 128 * 1024, CTLB_SSQ1 = 256 * 1024, CTLB_SSQ3 = 384 * 1024;
constexpr size_t WS_WIN = 1 * MiB, WS_WQ = 6 * MiB, WS_WKV = 6 * MiB + 512 * 1024, WS_WOUT = 7 * MiB, WS_WPG = 9 * MiB, WS_WPP = 11 * MiB;
constexpr size_t WS_WGU = 12 * MiB, WS_WDN = 140 * MiB;
constexpr size_t WS_CS = 204 * MiB, WS_G = 212 * MiB, WS_KPE = 214 * MiB, WS_GATEW = 218 * MiB, WS_LIST = 219 * MiB, WS_LOCN = 223 * MiB, WS_MSC = 224 * MiB, WS_PB = 225 * MiB;
constexpr size_t WS_TOPI = 224 * MiB + 512 * 1024;
constexpr size_t WS_XN = 242 * MiB, WS_LOCC = 306 * MiB, WS_Y = 370 * MiB, WS_YS = 242 * MiB;
constexpr size_t WS_U = 498 * MiB, WS_Q = 658 * MiB, WS_KV = 706 * MiB, WS_HMID = 498 * MiB, WS_XN3 = 498 * MiB;
constexpr size_t WS_H1 = 770 * MiB, WS_PP = 898 * MiB, WS_END = 962 * MiB;
constexpr int CW_TMO = 0, CW_BAR = 4096, CW_CNT = 8192;

constexpr int RING_BYTES = 131072;
constexpr int LDS_TAB = 147456;
constexpr int LDS_MISC = LDS_TAB + 4608;
constexpr int LDS_BYTES = LDS_MISC + 256;

#define LDS_WAIT() asm volatile("s_waitcnt lgkmcnt(0)" ::: "memory")
#define VM_WAIT() asm volatile("s_waitcnt vmcnt(0)" ::: "memory")
#define SBAR() __builtin_amdgcn_sched_barrier(0)
__device__ __forceinline__ float bf2f(bf16_t x) { return __uint_as_float((unsigned)x << 16); }
__device__ __forceinline__ float bflo(unsigned w) { return __uint_as_float(w << 16); }
__device__ __forceinline__ float bfhi(unsigned w) { return __uint_as_float(w & 0xffff0000u); }
typedef __bf16 bf16x2n __attribute__((ext_vector_type(2)));
__device__ __forceinline__ unsigned cvt_pk_bf16(float lo, float hi) { const f32x2 v = {lo, hi}; return __builtin_bit_cast(unsigned, __builtin_convertvector(v, bf16x2n)); }
__device__ __forceinline__ unsigned cvt_pk4_fp8(float a, float b, float c, float d) {
    a = fminf(fmaxf(a, -448.f), 448.f); b = fminf(fmaxf(b, -448.f), 448.f); c = fminf(fmaxf(c, -448.f), 448.f); d = fminf(fmaxf(d, -448.f), 448.f);
    int w = 0; w = __builtin_amdgcn_cvt_pk_fp8_f32(a, b, w, false); w = __builtin_amdgcn_cvt_pk_fp8_f32(c, d, w, true); return (unsigned)w; }
__device__ __forceinline__ float wave_sum(float v) {
#pragma unroll
    for (int o = 1; o < 64; o <<= 1) v += __shfl_xor(v, o);
    return v;
}
__device__ __forceinline__ float fast_exp(float x) { return __builtin_amdgcn_exp2f(x * 1.4426950408889634f); }
__device__ __forceinline__ float sigmoid_f(float x) { return __builtin_amdgcn_rcpf(1.0f + fast_exp(-x)); }

struct Args {
    const float* in[26];
    float* out;
    unsigned char* ws;
    int ph_lo, ph_hi;
};

#define XB_TMO      128
#define XB_XCNT(j)  (256  + 64 * (j))
#define XB_XSUB(j)  (1280 + 64 * (j))
#define XB_XGEN(j)  (2304 + 64 * (j))
#define XB_TOP      3328
#define XB_TOPGEN   3392
#define XCD_BAR_WORDS 3456
#define XB_SPIN_CAP (1u << 20)

__device__ __forceinline__ unsigned xb_ld(unsigned* p)              { return __hip_atomic_load(p, __ATOMIC_RELAXED, __HIP_MEMORY_SCOPE_AGENT); }
__device__ __forceinline__ unsigned xb_add(unsigned* p, unsigned v) { return __hip_atomic_fetch_add(p, v, __ATOMIC_RELAXED, __HIP_MEMORY_SCOPE_AGENT); }
__device__ __forceinline__ unsigned xb_xcc_id() { return (unsigned)__builtin_amdgcn_s_getreg((3 << 11) | 20) & 0xFu; }
#define XB_SPIN(cond, bar) do { unsigned _sp = 0; while (cond) { __builtin_amdgcn_s_sleep(1); \
    if ((++_sp & 255u) == 0u) { if (xb_ld(&(bar)[XB_TMO])) break; if (_sp > XB_SPIN_CAP) { atomicAdd(&(bar)[XB_TMO], 1u); break; } } } } while (0)

struct XcdBarrier { unsigned* bar; unsigned x; volatile LAS unsigned* st; };

__device__ __forceinline__ XcdBarrier xcd_barrier_post(unsigned* bar, volatile LAS unsigned* st) {
    XcdBarrier b; b.bar = bar; b.x = xb_xcc_id(); b.st = st;
    if (threadIdx.x == 0) (void)xb_add(&bar[XB_XCNT(b.x)], 1u);
    return b;
}
__device__ __forceinline__ void xcd_barrier_complete(unsigned* bar, unsigned x, unsigned& nloc, unsigned& nx) {
    const unsigned G = gridDim.x * gridDim.y * gridDim.z;
    unsigned sum, cnt, mine, sp = 0u;
    for (;;) {
        sum = 0u; cnt = 0u; mine = 0u;
#pragma unroll
        for (unsigned j = 0; j < 16; ++j) { const unsigned c = xb_ld(&bar[XB_XCNT(j)]); sum += c; cnt += (c > 0u) ? 1u : 0u; mine = (j == x) ? c : mine; }
        if (sum == G) break;
        __builtin_amdgcn_s_sleep(1);
        if ((++sp & 255u) == 0u) { if (xb_ld(&bar[XB_TMO])) break; if (sp > XB_SPIN_CAP) { atomicAdd(&bar[XB_TMO], 1u); break; } }
    }
    nloc = mine > 0u ? mine : 1u; nx = cnt > 0u ? cnt : 1u;
}
__device__ __forceinline__ void xcd_barrier(const XcdBarrier& b) {
    asm volatile("s_waitcnt vmcnt(0)" ::: "memory");
    __syncthreads();
    if (threadIdx.x == 0) {
        unsigned* bar = b.bar;
        __builtin_amdgcn_s_waitcnt(0);
        unsigned nloc = b.st[0], nx = b.st[1];
        if (nloc == 0u) { xcd_barrier_complete(bar, b.x, nloc, nx); b.st[0] = nloc; b.st[1] = nx; }
        const unsigned old = xb_add(&bar[XB_XSUB(b.x)], 1u);
        const unsigned gen = old / nloc;
        if (old + 1u == (gen + 1u) * nloc) {
            __builtin_amdgcn_fence(__ATOMIC_RELEASE, "agent");
            asm volatile("s_waitcnt vmcnt(0)" ::: "memory");
            const unsigned og = xb_add(&bar[XB_TOP], 1u);
            const unsigned tg = og / nx;
            if (og + 1u == (tg + 1u) * nx) xb_add(&bar[XB_TOPGEN], 1u);
            else XB_SPIN(xb_ld(&bar[XB_TOPGEN]) == tg, bar);
            __builtin_amdgcn_fence(__ATOMIC_ACQUIRE, "agent");
            xb_add(&bar[XB_XGEN(b.x)], 1u);
            asm volatile("s_waitcnt vmcnt(0)" ::: "memory");
        } else {
            XB_SPIN(xb_ld(&bar[XB_XGEN(b.x)]) == gen, bar);
            __builtin_amdgcn_fence(__ATOMIC_ACQUIRE, "agent");
            asm volatile("s_waitcnt vmcnt(0)" ::: "memory");
        }
    }
    __syncthreads();
}

namespace pg8 {
constexpr int BM = 256, BK = 64, HALF = 128, HTB = HALF * BK * 2, STAGE_BYTES = 8 * HTB, NXCD = 8, WGM = 8;
__host__ __device__ __forceinline__ int lds_byte(int r, int c) { const int st = (r >> 4) * 2 + (c >> 5), rr = r & 15, cc = c & 31, ob = rr * 64 + cc * 2; return st * 1024 + (ob ^ (((ob >> 9) & 1) << 5)); }
__host__ __device__ __forceinline__ void stage_rc(int b, int& R, int& C) { const int st = b / 1024, sb = b % 1024, swz = sb ^ (((sb >> 9) & 1) << 5); R = (st >> 1) * 16 + swz / 64; C = (st & 1) * 32 + (swz % 64) / 2; }
__host__ __device__ __forceinline__ int perm32(int rho) { const int n = rho >> 4, i = rho & 15; return 8 * (i >> 2) + 4 * n + (i & 3); }

struct Unit { int pm, pn; };
typedef f32x4 Acc[2][2][4][2];

struct StaticOrder {
    int nM, nN, nwg, G, c;
    __device__ void init(int nM_, int nN_, int G_, int c_) { nM = nM_; nN = nN_; nwg = nM * nN; G = G_; c = c_; }
    __device__ __forceinline__ bool next(int i, Unit& u) const {
        const long L = (long)i * G + c; if (L >= nwg) return false;
        int wgid = (int)L; { const int q = nwg / NXCD, r = nwg % NXCD, xcd = wgid % NXCD, off = wgid / NXCD; wgid = (xcd < r ? xcd * (q + 1) : r * (q + 1) + (xcd - r) * q) + off; }
        const int nig = WGM * nN, gid = wgid / nig, fm = gid * WGM, gsz = (nM - fm) < WGM ? (nM - fm) : WGM;
        u.pm = fm + ((wgid % nig) % gsz); u.pn = (wgid % nig) / gsz; return true;
    }
};

template <class P>
__device__ __forceinline__ void gemm_phase(LAS unsigned char* lds, const P& p) {
    const int tid = threadIdx.x, wid = __builtin_amdgcn_readfirstlane(tid >> 6), lane = tid & 63, wr = wid >> 2, wc = wid & 3, fr = lane & 15, fq = lane >> 4;
    const int nt = p.K / BK;
    int Rr[2]; unsigned cA2[2], voffB[2];
#pragma unroll
    for (int i = 0; i < 2; ++i) { int R, C; stage_rc(tid * 16 + i * 8192, R, C); const int Rb = P::PERM ? ((R & ~31) + perm32(R & 31)) : R;
        Rr[i] = R; cA2[i] = (unsigned)C * 2u; voffB[i] = (unsigned)(Rb * p.ldb + C) * 2u; }
    const size_t kstep = (size_t)(BK * 2);
    const size_t hstepB = (size_t)HALF * p.ldb * 2;
    const unsigned ldsw = (unsigned)wid * 1024u;
    const int aoff = lds_byte(wr * 64 + fr, fq * 8), boff = lds_byte(wc * 32 + fr, fq * 8);
    const char* Ab = p.Abase;
#define PG8_SA(b, h) (((b) * 2 + (h)) * HTB)
#define PG8_SB(b, h) ((4 + (b) * 2 + (h)) * HTB)
#define PG8_STAGE_B(bufoff, gbase) do { _Pragma("unroll") for (int _i = 0; _i < 2; ++_i) \
        __builtin_amdgcn_global_load_lds((const unsigned*)((const char*)(gbase) + voffB[_i]), (LAS unsigned*)(lds + (bufoff) + ldsw + _i * 8192), 16, 0, 0); } while (0)
#define PG8_STAGE_A(bufoff, kb, v0, v1) do { \
        __builtin_amdgcn_global_load_lds((const unsigned*)(Ab + (kb) + (v0)), (LAS unsigned*)(lds + (bufoff) + ldsw), 16, 0, 0); \
        __builtin_amdgcn_global_load_lds((const unsigned*)(Ab + (kb) + (v1)), (LAS unsigned*)(lds + (bufoff) + ldsw + 8192), 16, 0, 0); } while (0)
#define PG8_LDA(dst, b, h) do { _Pragma("unroll") for (int m = 0; m < 4; ++m) _Pragma("unroll") for (int k = 0; k < 2; ++k) dst[m][k] = *(const LAS bf16x8*)(lds + PG8_SA(b, h) + aoff + m * 2048 + k * 1024); } while (0)
#define PG8_LDB(dst, b, h) do { _Pragma("unroll") for (int n = 0; n < 2; ++n) _Pragma("unroll") for (int k = 0; k < 2; ++k) dst[n][k] = *(const LAS bf16x8*)(lds + PG8_SB(b, h) + boff + n * 2048 + k * 1024); } while (0)
#define PG8_MMA(ai, bj, At, Bt) do { __builtin_amdgcn_s_setprio(1); _Pragma("unroll") for (int m = 0; m < 4; ++m) _Pragma("unroll") for (int n = 0; n < 2; ++n) _Pragma("unroll") for (int k = 0; k < 2; ++k) { \
        if constexpr (P::FP8) { const i64x2 a_ = __builtin_bit_cast(i64x2, At[m][k]), b_ = __builtin_bit_cast(i64x2, Bt[n][k]); \
            acc[ai][bj][m][n] = __builtin_amdgcn_mfma_f32_16x16x32_fp8_fp8(b_[0], a_[0], acc[ai][bj][m][n], 0, 0, 0); acc[ai][bj][m][n] = __builtin_amdgcn_mfma_f32_16x16x32_fp8_fp8(b_[1], a_[1], acc[ai][bj][m][n], 0, 0, 0); } \
        else acc[ai][bj][m][n] = __builtin_amdgcn_mfma_f32_16x16x32_bf16(Bt[n][k], At[m][k], acc[ai][bj][m][n], 0, 0, 0); } __builtin_amdgcn_s_setprio(0); } while (0)
#define PG8_WAIT_V(n) asm volatile("s_waitcnt vmcnt(" #n ")" ::: "memory")
#define PG8_WAIT_L(n) asm volatile("s_waitcnt lgkmcnt(" #n ")" ::: "memory")
#define PG8_BAR __builtin_amdgcn_s_barrier()
#define PG8_SCHED __builtin_amdgcn_sched_barrier(0)
    Unit cur, nxt; int ui = 0;
    if (!p.next(0, cur)) return;
    Acc acc;
#pragma unroll
    for (int a = 0; a < 2; ++a)
#pragma unroll
        for (int b = 0; b < 2; ++b)
#pragma unroll
            for (int m = 0; m < 4; ++m)
#pragma unroll
                for (int n = 0; n < 2; ++n) acc[a][b][m][n] = (f32x4){0.f, 0.f, 0.f, 0.f};
    bf16x8 At[4][2], B0[2][2], B1[2][2];
    unsigned vc00 = p.a_row_off(cur, Rr[0]) + cA2[0], vc01 = p.a_row_off(cur, Rr[1]) + cA2[1];
    unsigned vc10 = p.a_row_off(cur, HALF + Rr[0]) + cA2[0], vc11 = p.a_row_off(cur, HALF + Rr[1]) + cA2[1];
    const char* cB = p.b_tile(cur);
    PG8_STAGE_B(PG8_SB(0, 0), cB); PG8_STAGE_B(PG8_SB(0, 1), cB + hstepB); PG8_STAGE_A(PG8_SA(0, 0), 0, vc00, vc01); PG8_STAGE_A(PG8_SA(0, 1), 0, vc10, vc11);
    if (wr == 1) PG8_BAR;
    PG8_WAIT_V(2); PG8_BAR;
    PG8_STAGE_B(PG8_SB(1, 0), cB + kstep); PG8_STAGE_A(PG8_SA(1, 0), kstep, vc00, vc01); PG8_STAGE_B(PG8_SB(1, 1), cB + hstepB + kstep);
    PG8_WAIT_V(6); PG8_BAR;
    const int tload = nt >= 4 ? nt - 4 : 0;
    for (;;) {
        const bool has_next = p.next(ui + 1, nxt);
        unsigned vn00 = vc00, vn01 = vc01, vn10 = vc10, vn11 = vc11;
        const char* nB = has_next ? p.b_tile(nxt) : cB;
#pragma unroll 1
        for (int t = 0; t < nt; t += 2) {
            const bool last = (t == nt - 2);
            if (t == tload && has_next) {
                vn00 = p.a_row_off(nxt, Rr[0]) + cA2[0]; vn01 = p.a_row_off(nxt, Rr[1]) + cA2[1];
                vn10 = p.a_row_off(nxt, HALF + Rr[0]) + cA2[0]; vn11 = p.a_row_off(nxt, HALF + Rr[1]) + cA2[1];
            }
            if (p.tmid > 0 && t == p.tmid) p.mid(acc, cur, wr, wc, fr, fq);
            const size_t k1 = (size_t)(t + 1) * kstep, k2 = last ? 0 : (size_t)(t + 2) * kstep, k3 = k2 + kstep;
            const char* b2 = last ? nB : cB + (size_t)(t + 2) * kstep; const char* b3 = b2 + kstep;
            unsigned v200 = vc00, v201 = vc01, v210 = vc10, v211 = vc11;
            if (last) { v200 = vn00; v201 = vn01; v210 = vn10; v211 = vn11; }
            PG8_LDB(B0, 0, 0); PG8_LDB(B1, 0, 1); PG8_SCHED; PG8_LDA(At, 0, 0); PG8_STAGE_A(PG8_SA(1, 1), k1, vc10, vc11);
            PG8_WAIT_V(8); PG8_WAIT_L(0); PG8_BAR; PG8_MMA(0, 0, At, B0); PG8_MMA(0, 1, At, B1); PG8_BAR; PG8_SCHED;
            PG8_LDA(At, 0, 1); PG8_STAGE_B(PG8_SB(0, 0), b2); PG8_STAGE_B(PG8_SB(0, 1), b2 + hstepB); PG8_STAGE_A(PG8_SA(0, 0), k2, v200, v201);
            PG8_WAIT_V(8); PG8_WAIT_L(0); PG8_BAR; PG8_MMA(1, 0, At, B0); PG8_MMA(1, 1, At, B1); PG8_BAR; PG8_SCHED;
            PG8_LDB(B0, 1, 0); PG8_LDB(B1, 1, 1); PG8_SCHED; PG8_LDA(At, 1, 0); PG8_STAGE_A(PG8_SA(0, 1), k2, v210, v211);
            PG8_WAIT_V(8); PG8_WAIT_L(0); PG8_BAR; PG8_MMA(0, 0, At, B0); PG8_MMA(0, 1, At, B1); PG8_BAR; PG8_SCHED;
            PG8_LDA(At, 1, 1); PG8_STAGE_B(PG8_SB(1, 0), b3); PG8_STAGE_B(PG8_SB(1, 1), b3 + hstepB); PG8_STAGE_A(PG8_SA(1, 0), k3, v200, v201);
            PG8_WAIT_V(8); PG8_WAIT_L(0); PG8_BAR; PG8_MMA(1, 0, At, B0); PG8_MMA(1, 1, At, B1); PG8_BAR; PG8_SCHED;
        }
        if (wr == 0) PG8_BAR;
        p.epi(acc, cur, wr, wc, fr, fq);
        if (!has_next) break;
#pragma unroll
        for (int a = 0; a < 2; ++a)
#pragma unroll
            for (int b = 0; b < 2; ++b)
#pragma unroll
                for (int m = 0; m < 4; ++m)
#pragma unroll
                    for (int n = 0; n < 2; ++n) acc[a][b][m][n] = (f32x4){0.f, 0.f, 0.f, 0.f};
        cur = nxt; cB = nB; vc00 = vn00; vc01 = vn01; vc10 = vn10; vc11 = vn11; ++ui;
        if (wr == 1) PG8_BAR;
    }
    PG8_WAIT_V(0);
    PG8_BAR;
#undef PG8_SA
#undef PG8_SB
#undef PG8_STAGE_A
#undef PG8_STAGE_B
#undef PG8_LDA
#undef PG8_LDB
#undef PG8_MMA
#undef PG8_WAIT_V
#undef PG8_WAIT_L
#undef PG8_BAR
#undef PG8_SCHED
}
}
using pg8::Unit; using pg8::Acc;

struct DenseBase {
    static constexpr bool FP8 = false;
    const char* Abase; int lda; const bf16_t* Bt; int ldb; int K; int tmid;
    pg8::StaticOrder S;
    __device__ __forceinline__ bool next(int i, Unit& u) const { return S.next(i, u); }
    __device__ __forceinline__ unsigned a_row_off(const Unit& u, int r) const { return (unsigned)((u.pm * 256 + r) * lda) * 2u; }
    __device__ __forceinline__ const char* b_tile(const Unit& u) const { return (const char*)(Bt + (size_t)u.pn * 256 * ldb); }
    __device__ __forceinline__ void mid(Acc&, const Unit&, int, int, int, int) const {}
};

template <bool ROPE> struct ProbBf16 : DenseBase {
    static constexpr bool PERM = true;
    bf16_t* O; int ldc; int rope_pn; const float* cs;
    __device__ __forceinline__ void epi(Acc& acc, const Unit& u, int wr, int wc, int fr, int fq) const {
        asm volatile("" : "+v"(fr), "+v"(fq));
        const int row0 = u.pm * 256 + wr * 64 + fr, colt = u.pn * 256 + wc * 32 + 8 * fq;
        const bool rope = ROPE && (u.pn == rope_pn);
#pragma unroll
        for (int ai = 0; ai < 2; ++ai)
#pragma unroll
            for (int m = 0; m < 4; ++m) { const int row = row0 + ai * 128 + m * 16; bf16_t* rowp = O + (size_t)row * ldc + colt;
#pragma unroll
                for (int bj = 0; bj < 2; ++bj) { f32x4 v0 = acc[ai][bj][m][0], v1 = acc[ai][bj][m][1];
                    if (rope) { const int w = (bj * 128 + wc * 32 + 8 * fq) & 63, i0 = w >> 1;
                        const f32x4 c = *(const f32x4*)(cs + (size_t)row * 64 + i0), s = *(const f32x4*)(cs + (size_t)row * 64 + 32 + i0);
                        f32x4 a, b; a[0] = v0[0] * c[0] - v0[1] * s[0]; a[1] = v0[1] * c[0] + v0[0] * s[0]; a[2] = v0[2] * c[1] - v0[3] * s[1]; a[3] = v0[3] * c[1] + v0[2] * s[1];
                        b[0] = v1[0] * c[2] - v1[1] * s[2]; b[1] = v1[1] * c[2] + v1[0] * s[2]; b[2] = v1[2] * c[3] - v1[3] * s[3]; b[3] = v1[3] * c[3] + v1[2] * s[3]; v0 = a; v1 = b; }
                    u32x4 w4; w4.x = cvt_pk_bf16(v0[0], v0[1]); w4.y = cvt_pk_bf16(v0[2], v0[3]); w4.z = cvt_pk_bf16(v1[0], v1[1]); w4.w = cvt_pk_bf16(v1[2], v1[3]);
                    *(u32x4*)(rowp + bj * 128) = w4; } }
    }
};

struct ProbWout : DenseBase {
    static constexpr bool PERM = false;
    const float* x; float* H1; const float* ssqo; float* ssq1; float sqs;
    __device__ __forceinline__ void mid(Acc& acc, const Unit& u, int wr, int wc, int fr, int fq) const {
        asm volatile("" : "+v"(fr), "+v"(fq));
#pragma unroll
        for (int ai = 0; ai < 2; ++ai)
#pragma unroll
            for (int m = 0; m < 4; ++m) { const int row = u.pm * 256 + ai * 128 + wr * 64 + m * 16 + fr;
                const float sc = __builtin_amdgcn_rsqf(ssqo[row] * (1.0f / 512.0f) + EPS);
#pragma unroll
                for (int bj = 0; bj < 2; ++bj)
#pragma unroll
                    for (int n = 0; n < 2; ++n) acc[ai][bj][m][n] *= sc; }
    }
    __device__ __forceinline__ void epi(Acc& acc, const Unit& u, int wr, int wc, int fr, int fq) const {
        asm volatile("" : "+v"(fr), "+v"(fq));
        const int row0 = u.pm * 256 + wr * 64 + fr, col0 = u.pn * 256 + wc * 32 + 4 * fq;
#pragma unroll
        for (int ai = 0; ai < 2; ++ai)
#pragma unroll
            for (int m = 0; m < 4; ++m) { const int row = row0 + ai * 128 + m * 16; const size_t off = (size_t)row * DM + col0; float q = 0.f;
#pragma unroll
                for (int bj = 0; bj < 2; ++bj)
#pragma unroll
                    for (int n = 0; n < 2; ++n) { const f32x4 v = *(const f32x4*)(x + off + bj * 128 + n * 16) + (DBG_MODE == 2 ? 0.f : 1.f) * acc[ai][bj][m][n];
                        *(f32x4*)(H1 + off + bj * 128 + n * 16) = v; q += (v[0] * v[0] + v[1] * v[1]) + (v[2] * v[2] + v[3] * v[3]); }
                q += __shfl_xor(q, 16); q += __shfl_xor(q, 32);
                if (fq == 0) atomicAdd(ssq1 + row, q * sqs); }
    }
};

struct ProbPle : DenseBase {
    static constexpr bool PERM = false;
    const float* H2; const bf16_t* PP; float* out; float* ssq3; float sqs;
    __device__ __forceinline__ void epi(Acc& acc, const Unit& u, int wr, int wc, int fr, int fq) const {
        asm volatile("" : "+v"(fr), "+v"(fq));
        const int row0 = u.pm * 256 + wr * 64 + fr, col0 = u.pn * 256 + wc * 32 + 4 * fq;
#pragma unroll
        for (int ai = 0; ai < 2; ++ai)
#pragma unroll
            for (int m = 0; m < 4; ++m) { const int row = row0 + ai * 128 + m * 16; const size_t off = (size_t)row * DM + col0; float q = 0.f;
#pragma unroll
                for (int bj = 0; bj < 2; ++bj)
#pragma unroll
                    for (int n = 0; n < 2; ++n) { const f32x4 h = *(const f32x4*)(H2 + off + bj * 128 + n * 16); const u32x2 pw = *(const u32x2*)(PP + off + bj * 128 + n * 16);
                        const f32x4 a = acc[ai][bj][m][n]; f32x4 v;
                        if (DBG_MODE >= 1) { v = h; } else {
                        v[0] = h[0] + sigmoid_f(a[0]) * bflo(pw.x); v[1] = h[1] + sigmoid_f(a[1]) * bfhi(pw.x); v[2] = h[2] + sigmoid_f(a[2]) * bflo(pw.y); v[3] = h[3] + sigmoid_f(a[3]) * bfhi(pw.y); }
                        *(f32x4*)(out + off + bj * 128 + n * 16) = v; q += (v[0] * v[0] + v[1] * v[1]) + (v[2] * v[2] + v[3] * v[3]); }
                q += __shfl_xor(q, 16); q += __shfl_xor(q, 32);
                if (fq == 0) atomicAdd(ssq3 + row, q * sqs); }
    }
};

struct MoeOrder {
    const LAS int* tab; int T, nN, G, c;
    __device__ __forceinline__ bool next(int i, Unit& u) const {
        const int L = i * G + c, x = L & 7, s = L >> 3, q = s / nN; u.pn = s - q * nN; u.pm = x + 8 * q; return u.pm < T;
    }
};
struct ProbMoe1 {
    static constexpr bool PERM = true, FP8 = true;
    const char* Abase; const unsigned char* Wgu; int ldb; int K; int tmid; MoeOrder S;
    const int* list; const float* bgu; unsigned char* HMID;
    __device__ __forceinline__ bool next(int i, Unit& u) const { return S.next(i, u); }
    __device__ __forceinline__ unsigned a_row_off(const Unit& u, int r) const {
        const int t0 = S.tab[2 * u.pm], e = t0 & 255, cnt = t0 >> 8, r0 = S.tab[2 * u.pm + 1];
        const int slot = list[e * NTOK + r0 + (r < cnt ? r : 0)];
        return (unsigned)((slot >> 2) * DM);
    }
    __device__ __forceinline__ const char* b_tile(const Unit& u) const { const int e = S.tab[2 * u.pm] & 255; return (const char*)(Wgu + ((size_t)e * 2048 + (size_t)u.pn * 256) * DM); }
    __device__ __forceinline__ void mid(Acc&, const Unit&, int, int, int, int) const {}
    __device__ __forceinline__ void epi(Acc& acc, const Unit& u, int wr, int wc, int fr, int fq) const {
        asm volatile("" : "+v"(fr), "+v"(fq));
        const int e = S.tab[2 * u.pm] & 255;
        const int j0 = u.pn * 128 + wc * 32 + 8 * fq;
        const float* bg = bgu + (size_t)e * 2048 + j0;
        const f32x4 bg0 = *(const f32x4*)bg, bg1 = *(const f32x4*)(bg + 4), bu0 = *(const f32x4*)(bg + 1024), bu1 = *(const f32x4*)(bg + 1028);
#pragma unroll
        for (int ai = 0; ai < 2; ++ai)
#pragma unroll
            for (int m = 0; m < 4; ++m) { const int row = u.pm * 256 + ai * 128 + wr * 64 + m * 16 + fr; float h[8];
#pragma unroll
                for (int n = 0; n < 2; ++n) { const f32x4 g4 = acc[ai][0][m][n] * (1.0f / 1024.0f) + (n ? bg1 : bg0), u4 = acc[ai][1][m][n] * (1.0f / 1024.0f) + (n ? bu1 : bu0);
#pragma unroll
                    for (int k = 0; k < 4; ++k) { const float g = fminf(g4[k], 7.0f), up = fminf(fmaxf(u4[k], -7.0f), 7.0f); h[n * 4 + k] = (up + 1.0f) * (g * sigmoid_f(1.702f * g)) * 4.0f; } }
                u32x2 w2; w2.x = cvt_pk4_fp8(h[0], h[1], h[2], h[3]); w2.y = cvt_pk4_fp8(h[4], h[5], h[6], h[7]);
                *(u32x2*)(HMID + (size_t)row * DM + j0) = w2; }
    }
};
struct ProbMoe2 {
    static constexpr bool PERM = true, FP8 = true;
    const char* Abase; const unsigned char* Wdn; int ldb; int K; int tmid; MoeOrder S;
    const int* list; const float* bdn; const float* gatew; bf16_t* YS;
    __device__ __forceinline__ bool next(int i, Unit& u) const { return S.next(i, u); }
    __device__ __forceinline__ unsigned a_row_off(const Unit& u, int r) const { return (unsigned)((u.pm * 256 + r) * DM); }
    __device__ __forceinline__ const char* b_tile(const Unit& u) const { const int e = S.tab[2 * u.pm] & 255; return (const char*)(Wdn + ((size_t)e * 1024 + (size_t)u.pn * 256) * DM); }
    __device__ __forceinline__ void mid(Acc&, const Unit&, int, int, int, int) const {}
    __device__ __forceinline__ void epi(Acc& acc, const Unit& u, int wr, int wc, int fr, int fq) const {
        asm volatile("" : "+v"(fr), "+v"(fq));
        const int t0 = S.tab[2 * u.pm], e = t0 & 255, cnt = t0 >> 8, r0 = S.tab[2 * u.pm + 1];
        const int colt = u.pn * 256 + wc * 32 + 8 * fq;
        f32x4 bv[2][2];
#pragma unroll
        for (int bj = 0; bj < 2; ++bj)
#pragma unroll
            for (int n = 0; n < 2; ++n) bv[bj][n] = *(const f32x4*)(bdn + (size_t)e * DM + colt + bj * 128 + 4 * n);
#pragma unroll
        for (int ai = 0; ai < 2; ++ai)
#pragma unroll
            for (int m = 0; m < 4; ++m) { const int r = ai * 128 + wr * 64 + m * 16 + fr;
                if (r < cnt) { const int slot = list[e * NTOK + r0 + r]; const float gw = gatew[slot]; bf16_t* rowp = YS + (size_t)slot * DM + colt;
#pragma unroll
                    for (int bj = 0; bj < 2; ++bj) { const f32x4 v0 = (acc[ai][bj][m][0] * (1.0f / 256.0f) + bv[bj][0]) * gw, v1 = (acc[ai][bj][m][1] * (1.0f / 256.0f) + bv[bj][1]) * gw;
                        u32x4 w4; w4.x = cvt_pk_bf16(v0[0], v0[1]); w4.y = cvt_pk_bf16(v0[2], v0[3]); w4.z = cvt_pk_bf16(v1[0], v1[1]); w4.w = cvt_pk_bf16(v1[2], v1[3]);
                        *(u32x4*)(rowp + bj * 128) = w4; } } }
    }
};

struct TrTile { f32x4 v[16]; };
template <class KS>
__device__ __forceinline__ void tr_load(TrTile& t, const float* __restrict__ W, int N, int item, int lane, KS ks) {
    const int nblk = (N + 63) >> 6, kb = item / nblk, nb = item - kb * nblk, k0 = 64 * kb, n = 64 * nb + 4 * (lane & 15);
#pragma unroll
    for (int i = 0; i < 16; ++i) { const int k = k0 + 4 * i + (lane >> 4); t.v[i] = (f32x4){0.f, 0.f, 0.f, 0.f}; if (n < N) t.v[i] = *(const f32x4*)(W + (size_t)k * N + n) * ks(k); }
}
template <class Map>
__device__ __forceinline__ void tr_store(const TrTile& t, int N, bf16_t* __restrict__ WT, int ldt, int koff, int kmask, LAS float* scr, int item, int lane, Map map) {
    const int nblk = (N + 63) >> 6, kb = item / nblk, nb = item - kb * nblk, k0 = 64 * kb, n0 = 64 * nb;
#pragma unroll
    for (int i = 0; i < 16; ++i) *(LAS f32x4*)(scr + (4 * i + (lane >> 4)) * 68 + 4 * (lane & 15)) = t.v[i];
    LDS_WAIT(); asm volatile("" ::: "memory");
    const int src = n0 + lane;
    if (src < N) { bf16_t* orow = WT + (size_t)map(src) * ldt;
#pragma unroll
        for (int c = 0; c < 8; ++c) { const LAS float* sp = scr + (8 * c) * 68 + lane;
            u32x4 o; o.x = cvt_pk_bf16(sp[0 * 68], sp[1 * 68]); o.y = cvt_pk_bf16(sp[2 * 68], sp[3 * 68]); o.z = cvt_pk_bf16(sp[4 * 68], sp[5 * 68]); o.w = cvt_pk_bf16(sp[6 * 68], sp[7 * 68]);
            *(u32x4*)(orow + ((k0 + 8 * c + koff) & kmask)) = o; } }
    LDS_WAIT(); asm volatile("" ::: "memory");
}
template <class Map>
__device__ __forceinline__ void tr_store_fp8(const TrTile& t, int N, unsigned char* __restrict__ WT, int ldt, float scale, LAS float* scr, int item, int lane, Map map) {
    const int nblk = (N + 63) >> 6, kb = item / nblk, nb = item - kb * nblk, k0 = 64 * kb, n0 = 64 * nb;
#pragma unroll
    for (int i = 0; i < 16; ++i) *(LAS f32x4*)(scr + (4 * i + (lane >> 4)) * 68 + 4 * (lane & 15)) = t.v[i];
    LDS_WAIT(); asm volatile("" ::: "memory");
    const int src = n0 + lane;
    if (src < N) { unsigned char* orow = WT + (size_t)map(src) * ldt + k0;
#pragma unroll
        for (int c = 0; c < 4; ++c) { const LAS float* sp = scr + (16 * c) * 68 + lane; u32x4 o;
#pragma unroll
            for (int q = 0; q < 4; ++q) o[q] = cvt_pk4_fp8(sp[(4 * q) * 68] * scale, sp[(4 * q + 1) * 68] * scale, sp[(4 * q + 2) * 68] * scale, sp[(4 * q + 3) * 68] * scale);
            *(u32x4*)(orow + 16 * c) = o; } }
    LDS_WAIT(); asm volatile("" ::: "memory");
}
struct KsOne { __device__ __forceinline__ float operator()(int) const { return 1.0f; } };
struct KsWout { const float* g; __device__ __forceinline__ float operator()(int k) const { return k >= 512 ? g[k - 512] : 1.0f; } };
struct MapId { __device__ __forceinline__ int operator()(int n) const { return n; } };
struct MapWin { __device__ __forceinline__ int operator()(int n) const {
    if (n < 2048) return n;
    if (n < 2064) return UC_G + (n - 2048);
    if (n < 2320) return UC_CQ + (n - 2064);
    if (n < 2448) return UC_CKV + (n - 2320);
    const int j = n - 2448; return UC_KR + 2 * (j & 31) + (j >> 5); } };
struct MapWq { __device__ __forceinline__ int operator()(int n) const {
    const int h = n / 192, j = n - h * 192; if (j < 128) return h * 128 + j; const int r = j - 128; return 512 + h * 64 + 2 * (r & 31) + (r >> 5); } };
struct MapWkv { __device__ __forceinline__ int operator()(int n) const {
    const int h = n >> 8, j = n & 255; return j < 128 ? h * 128 + j : 512 + h * 128 + (j - 128); } };
struct MapWgu { __device__ __forceinline__ int operator()(int n) const {
    const int up = n >> 10, j = n & 1023; return 256 * (j >> 7) + 128 * up + (j & 127); } };

__device__ __forceinline__ void p0_prologue(const Args& a, LAS unsigned char* lds, int vcu, int G) {
    const int tid = threadIdx.x, lane = tid & 63, wave = __builtin_amdgcn_readfirstlane(tid >> 6);
    unsigned char* ws = a.ws;
    LAS float* scr = (LAS float*)(lds + wave * 17408);
    const int gw = vcu * 8 + wave, NGW = G * 8;
    bf16_t* WIN = (bf16_t*)(ws + WS_WIN); bf16_t* WQ = (bf16_t*)(ws + WS_WQ); bf16_t* WKV = (bf16_t*)(ws + WS_WKV); bf16_t* WOUT = (bf16_t*)(ws + WS_WOUT);
    bf16_t* WPG = (bf16_t*)(ws + WS_WPG); bf16_t* WPP = (bf16_t*)(ws + WS_WPP); unsigned char* WGU = ws + WS_WGU; unsigned char* WDN = ws + WS_WDN;
    constexpr int I_IN = 16 * 40, I_Q = 4 * 12, I_KV = 2 * 16, I_OUT = 16 * 16, I_PG = 16 * 16, I_PP = 4 * 16, I_GU1 = 16 * 32, I_DN1 = 16 * 16;
    constexpr int I_SMALL = I_IN + I_Q + I_KV + I_OUT + I_PG + I_PP, I_GU = NEXP * I_GU1, I_DN = NEXP * I_DN1, NITEMS = I_SMALL + I_GU + I_DN;
#define TR_DISPATCH(OP_GU, OP_DN, OP_IN, OP_Q, OP_KV, OP_OUT, OP_PG, OP_PP, it) do { int r = (it); \
        if (r < I_GU) { const int e = r / I_GU1; r -= e * I_GU1; OP_GU; break; } r -= I_GU; \
        if (r < I_DN) { const int e = r / I_DN1; r -= e * I_DN1; OP_DN; break; } r -= I_DN; \
        if (r < I_IN) { OP_IN; break; } r -= I_IN; if (r < I_Q) { OP_Q; break; } r -= I_Q; if (r < I_KV) { OP_KV; break; } r -= I_KV; \
        if (r < I_OUT) { OP_OUT; break; } r -= I_OUT; if (r < I_PG) { OP_PG; break; } r -= I_PG; OP_PP; } while (0)
#define TR_LOAD(T, it) TR_DISPATCH(tr_load(T, a.in[18] + (size_t)e * 1024 * 2048, 2048, r, lane, KsOne()), tr_load(T, a.in[20] + (size_t)e * 1024 * 1024, 1024, r, lane, KsOne()), \
        tr_load(T, a.in[4], 2512, r, lane, KsOne()), tr_load(T, a.in[10], 768, r, lane, KsOne()), tr_load(T, a.in[12], 1024, r, lane, KsOne()), tr_load(T, a.in[14], 1024, r, lane, KsWout{a.in[13]}), \
        tr_load(T, a.in[23], 1024, r, lane, KsOne()), tr_load(T, a.in[24], 1024, r, lane, KsOne()), it)
#define TR_STORE(T, it) TR_DISPATCH(tr_store_fp8(T, 2048, WGU + (size_t)e * 2048 * 1024, 1024, 64.0f, scr, r, lane, MapWgu()), tr_store_fp8(T, 1024, WDN + (size_t)e * 1024 * 1024, 1024, 64.0f, scr, r, lane, MapId()), \
        tr_store(T, 2512, WIN, 1024, 0, 0x7fffffff, scr, r, lane, MapWin()), tr_store(T, 768, WQ, 256, 0, 0x7fffffff, scr, r, lane, MapWq()), tr_store(T, 1024, WKV, 256, 0, 0x7fffffff, scr, r, lane, MapWkv()), \
        tr_store(T, 1024, WOUT, 1024, 512, 1023, scr, r, lane, MapId()), tr_store(T, 1024, WPG, 1024, 0, 0x7fffffff, scr, r, lane, MapId()), tr_store(T, 1024, WPP, 256, 0, 0x7fffffff, scr, r, lane, MapId()), it)
    { TrTile tA, tB; int it = gw;
      if (it < NITEMS) TR_LOAD(tA, it);
      while (it < NITEMS) {
          const int i1 = it + NGW; if (i1 < NITEMS) TR_LOAD(tB, i1);
          TR_STORE(tA, it);
          if (i1 >= NITEMS) break;
          const int i2 = i1 + NGW; if (i2 < NITEMS) TR_LOAD(tA, i2);
          TR_STORE(tB, i1);
          it = i2; } }
#undef TR_LOAD
#undef TR_STORE
#undef TR_DISPATCH
    const int gt = vcu * 512 + tid, NGT = G * 512;
    for (int i = gt; i < 48 * 1024 / 8; i += NGT) *(u32x4*)(WIN + (size_t)2512 * 1024 + (size_t)i * 8) = (u32x4){0u, 0u, 0u, 0u};
    for (int i = gt; i < 1024 * 16; i += NGT) *(u32x4*)(WKV + (size_t)(i >> 4) * 256 + 128 + (i & 15) * 8) = (u32x4){0u, 0u, 0u, 0u};
    { const float* p = a.in[1]; bf16_t* PB = (bf16_t*)(ws + WS_PB);
      for (int i0 = gt; i0 < NTOK * 256 / 8; i0 += 4 * NGT) { f32x4 x0[4], x1[4];
#pragma unroll
          for (int q = 0; q < 4; ++q) { const size_t i = (size_t)i0 + (size_t)q * NGT; x0[q] = *(const f32x4*)(p + i * 8); x1[q] = *(const f32x4*)(p + i * 8 + 4); }
#pragma unroll
          for (int q = 0; q < 4; ++q) { const size_t i = (size_t)i0 + (size_t)q * NGT;
              u32x4 o; o.x = cvt_pk_bf16(x0[q][0], x0[q][1]); o.y = cvt_pk_bf16(x0[q][2], x0[q][3]); o.z = cvt_pk_bf16(x1[q][0], x1[q][1]); o.w = cvt_pk_bf16(x1[q][2], x1[q][3]); *(u32x4*)(PB + i * 8) = o; } } }
    { const float* x = a.in[0]; const float* g = a.in[3]; bf16_t* XN = (bf16_t*)(ws + WS_XN);
      f32x4 gv[4];
#pragma unroll
      for (int j = 0; j < 4; ++j) gv[j] = *(const f32x4*)(g + 4 * lane + 256 * j);
      for (int m0 = gw * 4; m0 < NTOK; m0 += NGW * 4) { f32x4 v[4][4];
#pragma unroll
          for (int r = 0; r < 4; ++r) { const f32x4* xr = (const f32x4*)(x + (size_t)(m0 + r) * DM) + lane;
#pragma unroll
              for (int j = 0; j < 4; ++j) v[r][j] = xr[64 * j]; }
#pragma unroll
          for (int r = 0; r < 4; ++r) { float s = 0.f;
#pragma unroll
              for (int j = 0; j < 4; ++j) s += (v[r][j][0] * v[r][j][0] + v[r][j][1] * v[r][j][1]) + (v[r][j][2] * v[r][j][2] + v[r][j][3] * v[r][j][3]);
              const float rstd = __builtin_amdgcn_rsqf(wave_sum(s) * (1.0f / DM) + EPS);
              u32x2* o8 = (u32x2*)(XN + (size_t)(m0 + r) * DM) + lane;
#pragma unroll
              for (int j = 0; j < 4; ++j) { u32x2 o; o.x = cvt_pk_bf16(v[r][j][0] * rstd * gv[j][0], v[r][j][1] * rstd * gv[j][1]); o.y = cvt_pk_bf16(v[r][j][2] * rstd * gv[j][2], v[r][j][3] * rstd * gv[j][3]); o8[64 * j] = o; } } } }
}

__device__ __forceinline__ void p2_tail(const Args& a, int vcu, int G) {
    const int tid = threadIdx.x, lane = tid & 63, wave = __builtin_amdgcn_readfirstlane(tid >> 6);
    unsigned char* ws = a.ws; const int gw = vcu * 8 + wave, NGW = G * 8;
    bf16_t* U = (bf16_t*)(ws + WS_U); float* CS = (float*)(ws + WS_CS); float* GG = (float*)(ws + WS_G); bf16_t* KPE = (bf16_t*)(ws + WS_KPE);
    const int* positions = (const int*)a.in[2];
    const f32x4 qg = *(const f32x4*)(a.in[9] + 4 * lane); const f32x2 kg = *(const f32x2*)(a.in[11] + 2 * lane);
    const float bgate = lane < 16 ? a.in[5][lane] : 0.f;
    const float freq = __builtin_amdgcn_exp2f(-(float)(lane >> 1) * (13.287712379549449f / 32.0f)) * 0.15915494309189535f;
    for (int m0 = gw * 4; m0 < NTOK; m0 += NGW * 4) {
        u32x2 cqw[4]; unsigned ckw[4]; float krv[4], gvv[4], posf[4];
#pragma unroll
        for (int r = 0; r < 4; ++r) { const bf16_t* ur = U + (size_t)(m0 + r) * NU;
            cqw[r] = *(const u32x2*)(ur + UC_CQ + 4 * lane); ckw[r] = *(const unsigned*)(ur + UC_CKV + 2 * lane);
            krv[r] = bf2f(ur[UC_KR + lane]); gvv[r] = lane < 16 ? bf2f(ur[UC_G + lane]) : 0.f; posf[r] = (float)positions[m0 + r]; }
#pragma unroll
        for (int r = 0; r < 4; ++r) { const int m = m0 + r; bf16_t* ur = U + (size_t)m * NU;
            const float q0 = bflo(cqw[r].x), q1 = bfhi(cqw[r].x), q2 = bflo(cqw[r].y), q3 = bfhi(cqw[r].y), k0 = bflo(ckw[r]), k1 = bfhi(ckw[r]);
            const float rq = __builtin_amdgcn_rsqf(wave_sum((q0 * q0 + q1 * q1) + (q2 * q2 + q3 * q3)) * (1.0f / 256.0f) + EPS);
            const float rk = __builtin_amdgcn_rsqf(wave_sum(k0 * k0 + k1 * k1) * (1.0f / 128.0f) + EPS);
            u32x2 qo; qo.x = cvt_pk_bf16(q0 * rq * qg[0], q1 * rq * qg[1]); qo.y = cvt_pk_bf16(q2 * rq * qg[2], q3 * rq * qg[3]);
            *(u32x2*)(ur + UC_CQ + 4 * lane) = qo; *(unsigned*)(ur + UC_CKV + 2 * lane) = cvt_pk_bf16(k0 * rk * kg[0], k1 * rk * kg[1]);
            float rev = posf[r] * freq; rev -= __builtin_rintf(rev);
            const float cs = __builtin_amdgcn_cosf(rev), sn = __builtin_amdgcn_sinf(rev);
            const float other = __shfl_xor(krv[r], 1);
            const float ro = (lane & 1) ? (krv[r] * cs + other * sn) : (krv[r] * cs - other * sn);
            const unsigned rw = cvt_pk_bf16(ro, __shfl_xor(ro, 1));
            if (!(lane & 1)) { *(unsigned*)(KPE + (size_t)m * 64 + lane) = rw; CS[(size_t)m * 64 + (lane >> 1)] = cs; CS[(size_t)m * 64 + 32 + (lane >> 1)] = sn; }
            if (lane < 16) { float g = gvv[r] + bgate; if ((lane >> 2) & 1) g = fminf(g, 0.f) - __logf(1.0f + __expf(-fabsf(g))); GG[(size_t)m * 16 + lane] = g; } }
    }
}

constexpr int LDP = 136;
constexpr int IMG = 128 * LDP * 2;
__device__ __forceinline__ unsigned lds_addr(const LAS void* p) { return (unsigned)(unsigned long)p; }
__device__ __forceinline__ bf16x8 frag_row(const LAS bf16_t* img, int row, int col) { return *(const LAS bf16x8*)(img + row * LDP + col); }
__device__ __forceinline__ void frag_tr_issue(const LAS bf16_t* img, int k0, int x0, int lane, s16x4& lo, s16x4& hi) {
    const int g = lane >> 4, i = lane & 15, q = i >> 2, p = i & 3;
    const unsigned ad = lds_addr(img + (k0 + 8 * g + q) * LDP + x0 + 4 * p);
    asm volatile("ds_read_b64_tr_b16 %0, %1" : "=v"(lo) : "v"(ad) : "memory");
    asm volatile("ds_read_b64_tr_b16 %0, %1 offset:%2" : "=v"(hi) : "v"(ad), "i"(4 * LDP * 2) : "memory");
}
#define PK8(L, H) (bf16x8){L[0], L[1], L[2], L[3], H[0], H[1], H[2], H[3]}

template <bool MAX> __device__ __forceinline__ void scan128(float a0, float a1, int lane, float& o0, float& o1) {
    float inc = MAX ? fmaxf(a0, a1) : a0 + a1;
#pragma unroll
    for (int off = 1; off < 64; off <<= 1) { const float y = __shfl_up(inc, off); if (lane >= off) inc = MAX ? fmaxf(inc, y) : inc + y; }
    float ex = __shfl_up(inc, 1); if (lane == 0) ex = MAX ? -INFINITY : 0.f;
    o0 = MAX ? fmaxf(ex, a0) : ex + a0; o1 = MAX ? fmaxf(o0, a1) : o0 + a1;
}
struct GateLds { LAS float* gi; LAS float* bc; LAS float* gg; LAS float* cm; LAS float* ee; LAS float* sc; };
__device__ __forceinline__ GateLds gate_lds(LAS unsigned char* base) {
    GateLds g; g.gi = (LAS float*)base; g.bc = g.gi + 512; g.gg = g.bc + 256; g.cm = g.gg + 256; g.ee = g.cm + 256; g.sc = g.ee + 256; return g;
}
__device__ __forceinline__ void gate_scans(const GateLds& L, int wave, int lane) {
    if (wave < 2) {
        const int d = wave, t0 = d ? 127 - 2 * lane : 2 * lane, t1 = d ? 126 - 2 * lane : 2 * lane + 1;
        const float i0 = L.gi[256 * d + t0], i1 = L.gi[256 * d + t1], f0 = L.gi[256 * d + 128 + t0], f1 = L.gi[256 * d + 128 + t1];
        float b0, b1; scan128<false>(f0, f1, lane, b0, b1);
        const float g0 = i0 - b0, g1 = i1 - b1; float c0, c1; scan128<true>(g0, g1, lane, c0, c1);
        const float gmax = __shfl(c1, 63), btot = __shfl(b1, 63);
        L.bc[128 * d + t0] = b0; L.bc[128 * d + t1] = b1; L.gg[128 * d + t0] = g0; L.gg[128 * d + t1] = g1; L.cm[128 * d + t0] = c0; L.cm[128 * d + t1] = c1;
        L.ee[128 * d + t0] = fast_exp(g0 - gmax); L.ee[128 * d + t1] = fast_exp(g1 - gmax);
        if (lane == 0) { L.sc[d] = btot; L.sc[2 + d] = gmax; }
    }
}
__device__ __forceinline__ void stage_conv(const bf16_t* __restrict__ U, int tokbase, int spos, int ucol, const float* __restrict__ cw, const float* __restrict__ cb, float scale, LAS bf16_t* dst, int tid) {
    const int cg = tid & 15, c0 = ucol + cg * 8, r0 = tid >> 4;
    float w0[8], w1[8], w2[8], bb[8];
#pragma unroll
    for (int e = 0; e < 8; ++e) { w0[e] = cw[c0 + e]; w1[e] = cw[1024 + c0 + e]; w2[e] = cw[2048 + c0 + e]; bb[e] = cb[c0 + e]; }
#pragma unroll
    for (int j = 0; j < 4; ++j) { const int r = r0 + 32 * j, s = spos + r; const bf16_t* up = U + (size_t)(tokbase + r) * NU + c0;
        const u32x4 z = (u32x4){0u, 0u, 0u, 0u};
        const u32x4 xm = s > 0 ? *(const u32x4*)(up - NU) : z, x0 = *(const u32x4*)up, xp = s < SEQ - 1 ? *(const u32x4*)(up + NU) : z;
        float o[8];
#pragma unroll
        for (int e = 0; e < 4; ++e) { const float a0 = bflo(xm[e]), a1 = bfhi(xm[e]), b0 = bflo(x0[e]), b1 = bfhi(x0[e]), c0_ = bflo(xp[e]), c1_ = bfhi(xp[e]);
            float v0 = w0[2 * e] * a0 + w1[2 * e] * b0 + w2[2 * e] * c0_ + bb[2 * e], v1 = w0[2 * e + 1] * a1 + w1[2 * e + 1] * b1 + w2[2 * e + 1] * c1_ + bb[2 * e + 1];
            o[2 * e] = v0 * sigmoid_f(v0) * scale; o[2 * e + 1] = v1 * sigmoid_f(v1) * scale; }
        u32x4 w; w.x = cvt_pk_bf16(o[0], o[1]); w.y = cvt_pk_bf16(o[2], o[3]); w.z = cvt_pk_bf16(o[4], o[5]); w.w = cvt_pk_bf16(o[6], o[7]);
        *(LAS u32x4*)(dst + r * LDP + cg * 8) = w; }
}

__device__ __forceinline__ void mlstm_local(const Args& a, LAS unsigned char* lds, int unit) {
    int tid = threadIdx.x; asm volatile("" : "+v"(tid)); const int lane = tid & 63, wave = __builtin_amdgcn_readfirstlane(tid >> 6);
    unsigned char* ws = a.ws;
    const bf16_t* U = (const bf16_t*)(ws + WS_U); const float* GG = (const float*)(ws + WS_G);
    bf16_t* LOCC = (bf16_t*)(ws + WS_LOCC); float* LOCN = (float*)(ws + WS_LOCN); float* MSC = (float*)(ws + WS_MSC);
    const int c = unit & 31, bh = unit >> 5, h = bh & 3, b = bh >> 2, tokbase = b * SEQ + c * 128;
    LAS bf16_t* Ks = (LAS bf16_t*)lds; LAS bf16_t* Vf = (LAS bf16_t*)(lds + IMG); LAS bf16_t* Vb = (LAS bf16_t*)(lds + 2 * IMG);
    const GateLds L = gate_lds(lds + 4 * IMG);
    { const int t = tid & 127, k = tid >> 7; L.gi[k * 128 + t] = GG[(size_t)(tokbase + t) * 16 + k * 4 + h]; }
    stage_conv(U, tokbase, c * 128, UC_K + h * 128, a.in[6], a.in[7], 0.08838834764831845f, Ks, tid);
    const int cg = tid & 15, r0 = tid >> 4; u32x4 vr[4];
#pragma unroll
    for (int j = 0; j < 4; ++j) vr[j] = *(const u32x4*)(U + (size_t)(tokbase + r0 + 32 * j) * NU + UC_V + h * 128 + cg * 8);
    __syncthreads();
    gate_scans(L, wave, lane);
    __syncthreads();
#pragma unroll
    for (int j = 0; j < 4; ++j) { const int r = r0 + 32 * j; const float ef = L.ee[r], eb = L.ee[128 + r]; u32x4 wf, wb;
#pragma unroll
        for (int e = 0; e < 4; ++e) { const float lo = bflo(vr[j][e]), hi = bfhi(vr[j][e]); wf[e] = cvt_pk_bf16(lo * ef, hi * ef); wb[e] = cvt_pk_bf16(lo * eb, hi * eb); }
        *(LAS u32x4*)(Vf + r * LDP + cg * 8) = wf; *(LAS u32x4*)(Vb + r * LDP + cg * 8) = wb; }
    __syncthreads();
    if (tid < 256) { const int d = tid >> 7, dk = tid & 127; float s = 0.f;
#pragma unroll 8
        for (int t = 0; t < 128; ++t) s += L.ee[128 * d + t] * bf2f(Ks[t * LDP + dk]);
        LOCN[(size_t)(unit * 2 + d) * 128 + dk] = s; }
    if (tid < 2) { MSC[(unit * 2 + tid) * 4 + 0] = L.sc[tid]; MSC[(unit * 2 + tid) * 4 + 1] = L.sc[tid] + L.sc[2 + tid]; }
    const int d = wave >> 2, dvb = 32 * (wave & 3); const LAS bf16_t* Vw = d ? Vb : Vf;
    f32x4 acc[2][8];
#pragma unroll
    for (int i = 0; i < 2; ++i)
#pragma unroll
        for (int j = 0; j < 8; ++j) acc[i][j] = (f32x4){0.f, 0.f, 0.f, 0.f};
#pragma unroll
    for (int ks = 0; ks < 4; ++ks) { s16x4 vl[2], vh[2], kl[8], kh[8];
#pragma unroll
        for (int i = 0; i < 2; ++i) frag_tr_issue(Vw, 32 * ks, dvb + 16 * i, lane, vl[i], vh[i]);
#pragma unroll
        for (int j = 0; j < 8; ++j) frag_tr_issue(Ks, 32 * ks, 16 * j, lane, kl[j], kh[j]);
        LDS_WAIT(); SBAR();
#pragma unroll
        for (int i = 0; i < 2; ++i)
#pragma unroll
            for (int j = 0; j < 8; ++j) acc[i][j] = __builtin_amdgcn_mfma_f32_16x16x32_bf16(PK8(kl[j], kh[j]), PK8(vl[i], vh[i]), acc[i][j], 0, 0, 0); }
    bf16_t* outp = LOCC + (size_t)(unit * 2 + d) * 16384;
#pragma unroll
    for (int i = 0; i < 2; ++i)
#pragma unroll
        for (int j = 0; j < 8; ++j) { u32x2 w; w.x = cvt_pk_bf16(acc[i][j][0], acc[i][j][1]); w.y = cvt_pk_bf16(acc[i][j][2], acc[i][j][3]);
            *(u32x2*)(outp + (dvb + 16 * i + (lane & 15)) * 128 + 16 * j + 4 * (lane >> 4)) = w; }
    __syncthreads();
}

__device__ __forceinline__ void mlstm_scan(const Args& a, int vcu, int G) {
    unsigned char* ws = a.ws; bf16_t* LOCC = (bf16_t*)(ws + WS_LOCC); float* LOCN = (float*)(ws + WS_LOCN); float* MSC = (float*)(ws + WS_MSC);
    const int gt = vcu * 512 + threadIdx.x, NGT = G * 512;
    for (int idx = gt; idx < 64 * 2048; idx += NGT) {
        const int seq = idx >> 11, e8 = idx & 2047, bh = seq >> 1, d = seq & 1;
        float st[8], sn[8]; float m = 0.f;
#pragma unroll
        for (int k = 0; k < 8; ++k) { st[k] = 0.f; sn[k] = 0.f; }
        const bool don = e8 < 16;
#pragma unroll 1
        for (int cb = 0; cb < 32; cb += 8) {
            u32x4 ld[8]; f32x4 n0[8], n1[8];
#pragma unroll
            for (int k = 0; k < 8; ++k) { const int c = d ? 31 - (cb + k) : cb + k; const int un = (bh * 32 + c) * 2 + d;
                ld[k] = *(const u32x4*)(LOCC + (size_t)un * 16384 + e8 * 8);
                if (DBG_MODE == 7) { const unsigned pat = 0x3c003c00u + (unsigned)((e8 * 7 + c) & 63); ld[k] = (u32x4){pat, pat, pat, pat}; }
                if (don) { n0[k] = *(const f32x4*)(LOCN + (size_t)un * 128 + e8 * 8); n1[k] = *(const f32x4*)(LOCN + (size_t)un * 128 + e8 * 8 + 4); } }
#pragma unroll
            for (int k = 0; k < 8; ++k) { const int c = d ? 31 - (cb + k) : cb + k; const int un = (bh * 32 + c) * 2 + d;
                const float bt = MSC[un * 4 + 0], mw = MSC[un * 4 + 1];
                const float mn = fmaxf(bt + m, mw), fa = fast_exp(bt + m - mn), fc = fast_exp(mw - mn);
                u32x4 pv; pv.x = cvt_pk_bf16(st[0], st[1]); pv.y = cvt_pk_bf16(st[2], st[3]); pv.z = cvt_pk_bf16(st[4], st[5]); pv.w = cvt_pk_bf16(st[6], st[7]);
                *(u32x4*)(LOCC + (size_t)un * 16384 + e8 * 8) = pv;
#pragma unroll
                for (int q = 0; q < 4; ++q) { st[2 * q] = fa * st[2 * q] + fc * bflo(ld[k][q]); st[2 * q + 1] = fa * st[2 * q + 1] + fc * bfhi(ld[k][q]); }
                if (don) { *(f32x4*)(LOCN + (size_t)un * 128 + e8 * 8) = (f32x4){sn[0], sn[1], sn[2], sn[3]}; *(f32x4*)(LOCN + (size_t)un * 128 + e8 * 8 + 4) = (f32x4){sn[4], sn[5], sn[6], sn[7]};
#pragma unroll
                    for (int q = 0; q < 4; ++q) { sn[q] = fa * sn[q] + fc * n0[k][q]; sn[4 + q] = fa * sn[4 + q] + fc * n1[k][q]; } }
                if (e8 == 0) MSC[un * 4 + 2] = m;
                m = mn; }
        }
    }
}

__device__ __forceinline__ void mlstm_out(const Args& a, LAS unsigned char* lds, int unit) {
    int tid = threadIdx.x; asm volatile("" : "+v"(tid)); const int lane = tid & 63, wave = __builtin_amdgcn_readfirstlane(tid >> 6);
    unsigned char* ws = a.ws;
    const bf16_t* U = (const bf16_t*)(ws + WS_U); const float* GG = (const float*)(ws + WS_G);
    const bf16_t* CPREV = (const bf16_t*)(ws + WS_LOCC); const float* NPREV = (const float*)(ws + WS_LOCN); const float* MSC = (const float*)(ws + WS_MSC);
    bf16_t* Y = (bf16_t*)(ws + WS_Y);
    const int c = unit & 31, bh = unit >> 5, h = bh & 3, b = bh >> 2, tokbase = b * SEQ + c * 128;
    LAS bf16_t* Qs = (LAS bf16_t*)lds; LAS bf16_t* Ks = (LAS bf16_t*)(lds + IMG); LAS bf16_t* CF = (LAS bf16_t*)(lds + 2 * IMG); LAS bf16_t* CB = (LAS bf16_t*)(lds + 3 * IMG);
    const GateLds L = gate_lds(lds + 4 * IMG);
    LAS float* np = (LAS float*)(lds + 4 * IMG + 6400); LAS float* mp = np + 256;
    { const int t = tid & 127, k = tid >> 7; L.gi[k * 128 + t] = GG[(size_t)(tokbase + t) * 16 + k * 4 + h]; }
    if (tid < 256) np[tid] = NPREV[(size_t)(unit * 2 + (tid >> 7)) * 128 + (tid & 127)];
    if (tid < 2) mp[tid] = MSC[(unit * 2 + tid) * 4 + 2];
    stage_conv(U, tokbase, c * 128, UC_Q + h * 128, a.in[6], a.in[7], 1.0f, Qs, tid);
    stage_conv(U, tokbase, c * 128, UC_K + h * 128, a.in[6], a.in[7], 0.08838834764831845f, Ks, tid);
#pragma unroll
    for (int d = 0; d < 2; ++d) { const bf16_t* src = CPREV + (size_t)(unit * 2 + d) * 16384; LAS bf16_t* dst = d ? CB : CF;
#pragma unroll
        for (int j = 0; j < 4; ++j) { const int v = tid + 512 * j; *(LAS u32x4*)(dst + (v >> 4) * LDP + (v & 15) * 8) = *(const u32x4*)(src + (size_t)v * 8); } }
    __syncthreads();
    gate_scans(L, wave, lane);
    __syncthreads();
    const int t0 = 16 * wave, tl = lane & 15, fq = lane >> 4, t = t0 + tl;
    bf16x8 qf[4];
#pragma unroll
    for (int ks = 0; ks < 4; ++ks) qf[ks] = frag_row(Qs, t, 32 * ks + 8 * fq);
    f32x4 sacc[8], accf[8], accb[8];
#pragma unroll
    for (int j = 0; j < 8; ++j) { sacc[j] = (f32x4){0.f, 0.f, 0.f, 0.f}; accf[j] = sacc[j]; accb[j] = sacc[j]; }
#pragma unroll
    for (int ks = 0; ks < 4; ++ks) {
#pragma unroll
        for (int jh = 0; jh < 2; ++jh) {
#pragma unroll
            for (int jj = 0; jj < 4; ++jj) { const int j = 4 * jh + jj;
                sacc[j] = __builtin_amdgcn_mfma_f32_16x16x32_bf16(frag_row(Ks, 16 * j + tl, 32 * ks + 8 * fq), qf[ks], sacc[j], 0, 0, 0);
                accf[j] = __builtin_amdgcn_mfma_f32_16x16x32_bf16(frag_row(CF, 16 * j + tl, 32 * ks + 8 * fq), qf[ks], accf[j], 0, 0, 0);
                accb[j] = __builtin_amdgcn_mfma_f32_16x16x32_bf16(frag_row(CB, 16 * j + tl, 32 * ks + 8 * fq), qf[ks], accb[j], 0, 0, 0); }
            SBAR(); } }
    float qnf = 0.f, qnb = 0.f;
#pragma unroll
    for (int k = 0; k < 4; ++k) { const bf16x8 qv = frag_row(Qs, t, 32 * fq + 8 * k);
#pragma unroll
        for (int e = 0; e < 8; ++e) { const float q = bf2f((bf16_t)qv[e]); qnf += q * np[32 * fq + 8 * k + e]; qnb += q * np[128 + 32 * fq + 8 * k + e]; } }
    qnf += __shfl_xor(qnf, 16); qnf += __shfl_xor(qnf, 32); qnb += __shfl_xor(qnb, 16); qnb += __shfl_xor(qnb, 32);
    const int cg = tid & 15, r0 = tid >> 4; u32x4 vr[4];
#pragma unroll
    for (int j = 0; j < 4; ++j) vr[j] = *(const u32x4*)(U + (size_t)(tokbase + r0 + 32 * j) * NU + UC_V + h * 128 + cg * 8);
    __syncthreads();
#pragma unroll
    for (int j = 0; j < 4; ++j) *(LAS u32x4*)(CF + (r0 + 32 * j) * LDP + cg * 8) = vr[j];
    const float Mf = fmaxf(mp[0], L.cm[t]), Mb = fmaxf(mp[1], L.cm[128 + t]);
    float rsf = 0.f, rsb = 0.f;
#pragma unroll
    for (int j = 0; j < 8; ++j) { const int s0 = 16 * j + 4 * fq; const f32x4 gf = *(const LAS f32x4*)(L.gg + s0), gb = *(const LAS f32x4*)(L.gg + 128 + s0);
        float pf[4], pb[4];
#pragma unroll
        for (int r = 0; r < 4; ++r) { const int s = s0 + r; const float wf = (s <= t) ? fast_exp(gf[r] - Mf) : 0.f, wb = (s >= t) ? fast_exp(gb[r] - Mb) : 0.f;
            pf[r] = sacc[j][r] * wf; pb[r] = sacc[j][r] * wb; rsf += pf[r]; rsb += pb[r]; }
        u32x2 wf2, wb2; wf2.x = cvt_pk_bf16(pf[0], pf[1]); wf2.y = cvt_pk_bf16(pf[2], pf[3]); wb2.x = cvt_pk_bf16(pb[0], pb[1]); wb2.y = cvt_pk_bf16(pb[2], pb[3]);
        *(LAS u32x2*)(Qs + t * LDP + s0) = wf2; *(LAS u32x2*)(Ks + t * LDP + s0) = wb2; }
    rsf += __shfl_xor(rsf, 16); rsf += __shfl_xor(rsf, 32); rsb += __shfl_xor(rsb, 16); rsb += __shfl_xor(rsb, 32);
    float af = fast_exp(mp[0] - Mf), ab = fast_exp(mp[1] - Mb);
    if (DBG_MODE == 5) { af = 0.f; ab = 0.f; }
#pragma unroll
    for (int j = 0; j < 8; ++j) { accf[j] *= (DBG_MODE == 6 ? 0.f : af); accb[j] *= (DBG_MODE == 6 ? 0.f : ab); }
    __syncthreads();
#pragma unroll
    for (int ks = 0; ks < 4; ++ks) { const bf16x8 pff = frag_row(Qs, t, 32 * ks + 8 * fq), pbf = frag_row(Ks, t, 32 * ks + 8 * fq);
        s16x4 vl[8], vh[8];
#pragma unroll
        for (int j = 0; j < 8; ++j) frag_tr_issue(CF, 32 * ks, 16 * j, lane, vl[j], vh[j]);
        LDS_WAIT(); SBAR();
#pragma unroll
        for (int j = 0; j < 8; ++j) { const bf16x8 vf = PK8(vl[j], vh[j]);
            accf[j] = __builtin_amdgcn_mfma_f32_16x16x32_bf16(vf, pff, accf[j], 0, 0, 0);
            accb[j] = __builtin_amdgcn_mfma_f32_16x16x32_bf16(vf, pbf, accb[j], 0, 0, 0); } }
    const float denf = rsf + af * qnf, denb = rsb + ab * qnb;
    const float invf = 1.0f / fmaxf(fabsf(denf), fast_exp(-(L.bc[t] + Mf))), invb = 1.0f / fmaxf(fabsf(denb), fast_exp(-(L.bc[128 + t] + Mb)));
    float ssq = 0.f;
#pragma unroll
    for (int j = 0; j < 8; ++j) { accf[j] = accf[j] * invf + accb[j] * invb; ssq += (accf[j][0] * accf[j][0] + accf[j][1] * accf[j][1]) + (accf[j][2] * accf[j][2] + accf[j][3] * accf[j][3]); }
    ssq += __shfl_xor(ssq, 16); ssq += __shfl_xor(ssq, 32);
    const float rstd = __builtin_amdgcn_rsqf(ssq * (1.0f / 128.0f) + EPS);
    const float* gn = a.in[8] + h * 128; const size_t tok = (size_t)(tokbase + t);
#pragma unroll
    for (int j = 0; j < 8; ++j) { const int dv = 16 * j + 4 * fq; const f32x4 g4 = *(const f32x4*)(gn + dv); const u32x2 ow = *(const u32x2*)(U + tok * NU + UC_O + h * 128 + dv);
        const float y0 = accf[j][0] * rstd * g4[0] * sigmoid_f(bflo(ow.x)), y1 = accf[j][1] * rstd * g4[1] * sigmoid_f(bfhi(ow.x));
        const float y2 = accf[j][2] * rstd * g4[2] * sigmoid_f(bflo(ow.y)), y3 = accf[j][3] * rstd * g4[3] * sigmoid_f(bfhi(ow.y));
        u32x2 w; w.x = cvt_pk_bf16(y0, y1); w.y = cvt_pk_bf16(y2, y3); if (DBG_MODE == 4) { w.x = 0u; w.y = 0u; }
        *(u32x2*)(Y + tok * DM + 512 + h * 128 + dv) = w; }
    __syncthreads();
}

namespace att {
constexpr int QBLK = 32, KVBLK = 64;
constexpr float SCALE = 0.07216878364870322f;
constexpr float THR = 8.f;
constexpr int LDQ = 768, LDK = 1024, LDR = 64;
constexpr int SHM_V = 16384, SHM_K = 16384, SHM_R = 8192;
constexpr int OFF_V = 0, OFF_K = 2 * SHM_V, OFF_R = OFF_K + 2 * SHM_K, OFF_WS = OFF_R + 2 * SHM_R, OFF_QR = OFF_WS + 2048;
#define KSWZ(row, colB) ((row) * 256 + ((colB) ^ (((row) & 7) << 4)))
#define RSWZ(row, colB) ((row) * 128 + ((colB) ^ (((row) & 7) << 4)))
__device__ __forceinline__ int crow(int r, int hi) { return (r & 3) + 8 * (r >> 2) + 4 * hi; }
__device__ __forceinline__ void partialSM(f32x16& p0, f32x16& p1, float& m_reg, float& mn, float& alpha) {
  constexpr float C = SCALE * 1.4426950408889634f;
  float pmax = p0[0];
#pragma unroll
  for (int r = 1; r < 16; ++r) pmax = fmaxf(pmax, p0[r]);
#pragma unroll
  for (int r = 0; r < 16; ++r) pmax = fmaxf(pmax, p1[r]);
  { auto rr = __builtin_amdgcn_permlane32_swap(__float_as_uint(pmax), __float_as_uint(pmax), false, false);
    pmax = fmaxf(__uint_as_float(rr[0]), __uint_as_float(rr[1])); }
  if (__builtin_expect(__all(pmax - m_reg <= THR / SCALE), 1)) { mn = m_reg; alpha = 1.f; }
  else { mn = fmaxf(m_reg, pmax); alpha = __builtin_amdgcn_exp2f((m_reg - mn) * C); m_reg = mn; }
  const float mnC = -mn * C;
#pragma unroll
  for (int r = 0; r < 16; ++r) p0[r] = fmaf(p0[r], C, mnC);
#pragma unroll
  for (int r = 0; r < 16; ++r) p1[r] = fmaf(p1[r], C, mnC);
#pragma unroll
  for (int r = 0; r < 16; ++r) p0[r] = __builtin_amdgcn_exp2f(p0[r]);
}
__device__ __forceinline__ void finishSM(f32x16& p0, f32x16& p1, float alpha, float& l_reg, bf16x8& pa0, bf16x8& pa1, bf16x8& pa2, bf16x8& pa3) {
#pragma unroll
  for (int r = 0; r < 16; ++r) p1[r] = __builtin_amdgcn_exp2f(p1[r]);
  float ps = 0;
#pragma unroll
  for (int r = 0; r < 16; ++r) ps += p0[r];
#pragma unroll
  for (int r = 0; r < 16; ++r) ps += p1[r];
  { auto rr = __builtin_amdgcn_permlane32_swap(__float_as_uint(ps), __float_as_uint(ps), false, false);
    ps = __uint_as_float(rr[0]) + __uint_as_float(rr[1]); }
  l_reg = l_reg * alpha + ps;
#define PK4(P, BASE, OUT) do { unsigned a0 = cvt_pk_bf16(P[BASE + 0], P[BASE + 1]), a1 = cvt_pk_bf16(P[BASE + 2], P[BASE + 3]);   \
    unsigned b0 = cvt_pk_bf16(P[BASE + 4], P[BASE + 5]), b1 = cvt_pk_bf16(P[BASE + 6], P[BASE + 7]);                              \
    auto r0 = __builtin_amdgcn_permlane32_swap(a0, b0, false, false); auto r1 = __builtin_amdgcn_permlane32_swap(a1, b1, false, false); \
    u32x4 w = {r0[0], r1[0], r0[1], r1[1]}; OUT = *reinterpret_cast<bf16x8*>(&w); } while (0)
  PK4(p0, 0, pa0); PK4(p0, 8, pa1); PK4(p1, 0, pa2); PK4(p1, 8, pa3);
#undef PK4
}
__device__ __forceinline__ void qkt(f32x16& p0, f32x16& p1, const LAS char* Ks, const LAS char* Rs, const bf16x8* qr, const LAS char* Qrs, int r32, int hi) {
  p0 = f32x16{}; p1 = f32x16{};
#pragma unroll
  for (int d0 = 0; d0 < 8; ++d0) { const int cb = (d0 * 16 + hi * 8) * 2;
    const bf16x8 b0 = *reinterpret_cast<const LAS bf16x8*>(Ks + KSWZ(r32, cb));
    const bf16x8 b1 = *reinterpret_cast<const LAS bf16x8*>(Ks + KSWZ(32 + r32, cb));
    p0 = __builtin_amdgcn_mfma_f32_32x32x16_bf16(b0, qr[d0], p0, 0, 0, 0);
    p1 = __builtin_amdgcn_mfma_f32_32x32x16_bf16(b1, qr[d0], p1, 0, 0, 0); }
#pragma unroll
  for (int d0 = 0; d0 < 4; ++d0) { const int cb = (d0 * 16 + hi * 8) * 2;
    const bf16x8 b0 = *reinterpret_cast<const LAS bf16x8*>(Rs + RSWZ(r32, cb));
    const bf16x8 b1 = *reinterpret_cast<const LAS bf16x8*>(Rs + RSWZ(32 + r32, cb));
    const bf16x8 qv = *reinterpret_cast<const LAS bf16x8*>(Qrs + RSWZ(r32, cb));
    p0 = __builtin_amdgcn_mfma_f32_32x32x16_bf16(b0, qv, p0, 0, 0, 0);
    p1 = __builtin_amdgcn_mfma_f32_32x32x16_bf16(b1, qv, p1, 0, 0, 0); }
}
__device__ __forceinline__ int v_st(int k, int c) { const int kk = (k & ~0xC) | ((k & 4) << 1) | ((k & 8) >> 1); return ((kk >> 3) * 4 + (c >> 5)) * 512 + ((kk & 7) * 32 + (c & 31)) * 2; }
__device__ __forceinline__ int v_rd_base(int lane) { return ((lane & 3) << 3) | (((lane >> 2) & 3) << 6) | (((lane >> 4) & 1) << 5) | (((lane >> 5) & 1) << 8); }
constexpr int v_rd_off(int d0, int ks, int half) { return d0 * 512 + ks * 4096 + half * 2048; }
template <int OFF> __device__ __forceinline__ s16x4 tr_read(int vb) {
  s16x4 r; asm volatile("ds_read_b64_tr_b16 %0, %1 offset:%2" : "=&v"(r) : "v"(vb), "i"(OFF) : "memory"); return r;
}
template <int D0> __device__ __forceinline__ void pv_one(f32x16& od, int vb, bf16x8 pa0, bf16x8 pa1, bf16x8 pa2, bf16x8 pa3) {
  const s16x4 l0 = tr_read<v_rd_off(D0, 0, 0)>(vb), h0 = tr_read<v_rd_off(D0, 0, 1)>(vb), l1 = tr_read<v_rd_off(D0, 1, 0)>(vb), h1 = tr_read<v_rd_off(D0, 1, 1)>(vb);
  const s16x4 l2 = tr_read<v_rd_off(D0, 2, 0)>(vb), h2 = tr_read<v_rd_off(D0, 2, 1)>(vb), l3 = tr_read<v_rd_off(D0, 3, 0)>(vb), h3 = tr_read<v_rd_off(D0, 3, 1)>(vb);
  asm volatile("s_waitcnt lgkmcnt(0)" ::: "memory"); SBAR();
  od = __builtin_amdgcn_mfma_f32_32x32x16_bf16(pa0, PK8(l0, h0), od, 0, 0, 0);
  od = __builtin_amdgcn_mfma_f32_32x32x16_bf16(pa1, PK8(l1, h1), od, 0, 0, 0);
  od = __builtin_amdgcn_mfma_f32_32x32x16_bf16(pa2, PK8(l2, h2), od, 0, 0, 0);
  od = __builtin_amdgcn_mfma_f32_32x32x16_bf16(pa3, PK8(l3, h3), od, 0, 0, 0);
}
__device__ __forceinline__ void pv_d0(f32x16* o, int vb, bf16x8 pa0, bf16x8 pa1, bf16x8 pa2, bf16x8 pa3) {
  pv_one<0>(o[0], vb, pa0, pa1, pa2, pa3); pv_one<1>(o[1], vb, pa0, pa1, pa2, pa3); pv_one<2>(o[2], vb, pa0, pa1, pa2, pa3); pv_one<3>(o[3], vb, pa0, pa1, pa2, pa3);
}
__device__ __forceinline__ void attn_unit(const bf16_t* __restrict__ Qn, const bf16_t* __restrict__ Qr, const bf16_t* __restrict__ Kh, const bf16_t* __restrict__ Vh, const bf16_t* __restrict__ Rh,
                                          bf16_t* __restrict__ Ob, float* __restrict__ ssq, float sqs, int seq, LAS unsigned char* lds) {
  int tid = threadIdx.x; asm volatile("" : "+v"(tid)); const int wid = tid >> 6, lane = tid & 63, r32 = lane & 31, hi = lane >> 5;
  LAS char* V_lds = (LAS char*)lds + OFF_V; LAS char* K_lds = (LAS char*)lds + OFF_K; LAS char* R_lds = (LAS char*)lds + OFF_R;
  LAS float* wsl = (LAS float*)(lds + OFF_WS) + wid * 64; LAS float* li_l = wsl; LAS float* al_l = wsl + 32;
  float m_reg = -1e30f, l_reg = 0; f32x16 o[4] = {}; bf16x8 qr[8];
  LAS char* Qrs = (LAS char*)lds + OFF_QR + wid * 4096;
  { const bf16_t* Qw = Qn + (size_t)(wid * QBLK + r32) * LDQ + hi * 8; const bf16_t* Qv = Qr + (size_t)(wid * QBLK + r32) * LDQ + hi * 8;
#pragma unroll
    for (int d0 = 0; d0 < 8; ++d0) qr[d0] = *reinterpret_cast<const bf16x8*>(Qw + d0 * 16);
#pragma unroll
    for (int d0 = 0; d0 < 4; ++d0) *(LAS bf16x8*)(Qrs + RSWZ(r32, (d0 * 16 + hi * 8) * 2)) = *reinterpret_cast<const bf16x8*>(Qv + d0 * 16); }
  const int sr = tid >> 4, sc = (tid & 15) * 8, vst0 = v_st(sr, sc), vst1 = v_st(32 + sr, sc);
  const int rr = tid >> 3, rc = (tid & 7) * 8;
  const int vb0 = (int)lds_addr(V_lds) + v_rd_base(lane);
  bf16x8 vs0, vs1, ks0, ks1, rs0;
#define SLOAD(k0) do { vs0 = *reinterpret_cast<const bf16x8*>(&Vh[(size_t)((k0) + sr) * LDK + sc]); vs1 = *reinterpret_cast<const bf16x8*>(&Vh[(size_t)((k0) + 32 + sr) * LDK + sc]); \
    ks0 = *reinterpret_cast<const bf16x8*>(&Kh[(size_t)((k0) + sr) * LDK + sc]); ks1 = *reinterpret_cast<const bf16x8*>(&Kh[(size_t)((k0) + 32 + sr) * LDK + sc]); \
    rs0 = *reinterpret_cast<const bf16x8*>(&Rh[(size_t)((k0) + rr) * LDR + rc]); } while (0)
#define SWRITE(b) do { *(LAS bf16x8*)(V_lds + (b) * SHM_V + vst0) = vs0; *(LAS bf16x8*)(V_lds + (b) * SHM_V + vst1) = vs1; const int kc = sc * 2;               \
    *(LAS bf16x8*)(K_lds + (b) * SHM_K + KSWZ(sr, kc)) = ks0; *(LAS bf16x8*)(K_lds + (b) * SHM_K + KSWZ(32 + sr, kc)) = ks1;                       \
    *(LAS bf16x8*)(R_lds + (b) * SHM_R + RSWZ(rr, rc * 2)) = rs0; } while (0)
#define RESC(a) do { if (__any((a) < 1.f)) { if (hi == 0) al_l[r32] = (a); asm volatile("s_waitcnt lgkmcnt(0)" ::: "memory"); \
    _Pragma("unroll") for (int d = 0; d < 4; ++d) _Pragma("unroll") for (int r = 0; r < 16; ++r) o[d][r] *= al_l[crow(r, hi)]; } } while (0)
  f32x16 pA0, pA1, pB0, pB1; float mnA, mnB, alA, alB; bf16x8 pa0, pa1, pa2, pa3; const int NT = seq / KVBLK;
  SLOAD(0); asm volatile("s_waitcnt vmcnt(0)" ::: "memory"); SWRITE(0); __syncthreads();
  qkt(pA0, pA1, K_lds, R_lds, qr, Qrs, r32, hi); partialSM(pA0, pA1, m_reg, mnA, alA);
  SLOAD(KVBLK);
  asm volatile("s_waitcnt vmcnt(0)" ::: "memory"); SWRITE(1); __syncthreads();
  for (int j = 1; j + 1 < NT; j += 2) {
    SBAR(); qkt(pB0, pB1, K_lds + SHM_K, R_lds + SHM_R, qr, Qrs, r32, hi);
    finishSM(pA0, pA1, alA, l_reg, pa0, pa1, pa2, pa3); SBAR();
    SLOAD((j + 1) * KVBLK); SBAR();
    pv_d0(o, vb0, pa0, pa1, pa2, pa3); partialSM(pB0, pB1, m_reg, mnB, alB);
    __syncthreads(); asm volatile("s_waitcnt vmcnt(0)" ::: "memory"); SWRITE(0);
    RESC(alB); __syncthreads();
    SBAR(); qkt(pA0, pA1, K_lds, R_lds, qr, Qrs, r32, hi);
    finishSM(pB0, pB1, alB, l_reg, pa0, pa1, pa2, pa3); SBAR();
    SLOAD((j + 2) * KVBLK); SBAR();
    pv_d0(o, vb0 + SHM_V, pa0, pa1, pa2, pa3); partialSM(pA0, pA1, m_reg, mnA, alA);
    __syncthreads(); asm volatile("s_waitcnt vmcnt(0)" ::: "memory"); SWRITE(1);
    RESC(alA); __syncthreads();
  }
  SBAR(); qkt(pB0, pB1, K_lds + SHM_K, R_lds + SHM_R, qr, Qrs, r32, hi);
  finishSM(pA0, pA1, alA, l_reg, pa0, pa1, pa2, pa3); SBAR();
  pv_d0(o, vb0, pa0, pa1, pa2, pa3); partialSM(pB0, pB1, m_reg, mnB, alB);
  __syncthreads(); RESC(alB);
  finishSM(pB0, pB1, alB, l_reg, pa0, pa1, pa2, pa3); SBAR();
  pv_d0(o, vb0 + SHM_V, pa0, pa1, pa2, pa3);
  if (hi == 0) li_l[r32] = l_reg; asm volatile("s_waitcnt lgkmcnt(0)" ::: "memory");
  bf16_t* Ow = Ob + (size_t)(wid * QBLK) * DM; float* sq = ssq + wid * QBLK;
#pragma unroll
  for (int r = 0; r < 16; ++r) { const int orow = crow(r, hi); const float rl = __builtin_amdgcn_rcpf(li_l[orow]); float q = 0.f;
#pragma unroll
    for (int d0 = 0; d0 < 4; ++d0) { const float v = o[d0][r] * rl; q += v * v; Ow[(size_t)orow * DM + d0 * 32 + r32] = (DBG_MODE == 3 || DBG_MODE >= 5) ? (bf16_t)0 : (bf16_t)(cvt_pk_bf16(v, v) & 0xffffu); }
    q += __shfl_xor(q, 1); q += __shfl_xor(q, 2); q += __shfl_xor(q, 4); q += __shfl_xor(q, 8); q += __shfl_xor(q, 16);
    if (r32 == r) atomicAdd(sq + orow, q * sqs); }
  __syncthreads();
#undef SLOAD
#undef SWRITE
#undef RESC
}
}

constexpr int RW_PITCH = 1032;
__device__ __forceinline__ void p7_router(const Args& a, LAS unsigned char* lds, int vcu, int G) {
    const int tid = threadIdx.x, lane = tid & 63, wave = __builtin_amdgcn_readfirstlane(tid >> 6);
    unsigned char* ws = a.ws;
    const float* H1 = (const float*)(ws + WS_H1); const float* ssq1 = (const float*)(ws + CTLB_SSQ1); unsigned char* XN2 = ws + WS_XN;
    float* GATEW = (float*)(ws + WS_GATEW); int* LIST = (int*)(ws + WS_LIST); unsigned* gcount = (unsigned*)(ws + WS_CTL) + CW_CNT;
    const float* gn = a.in[15]; const float* Wr = a.in[16]; const float* br = a.in[17];
    LAS bf16_t* Wh = (LAS bf16_t*)lds; LAS bf16_t* Wl = Wh + 32 * RW_PITCH;
    LAS float* lg = (LAS float*)(lds + 132096) + wave * 16 * 33;
    LAS int* lcount = (LAS int*)(lds + 132096 + 8 * 16 * 33 * 4);
    LAS int* lbase = lcount + 32; LAS int* lent = lbase + 32;
    for (int idx = tid; idx < 32 * 1024; idx += 512) { const int e = idx & 31, k = idx >> 5; const float w = Wr[idx] * gn[k];
        const unsigned hb = cvt_pk_bf16(w, w) & 0xffffu; const float wl = w - __uint_as_float(hb << 16);
        Wh[e * RW_PITCH + k] = (bf16_t)hb; Wl[e * RW_PITCH + k] = (bf16_t)(cvt_pk_bf16(wl, wl) & 0xffffu); }
    if (tid < 32) lcount[tid] = 0;
    __syncthreads();
    const int fr = lane & 15, fq = lane >> 4;
    for (int bi = vcu; bi < NTOK / 128; bi += G) {
        const int tok0 = bi * 128 + wave * 16, tok = tok0 + fr;
        const float rstd = __builtin_amdgcn_rsqf(ssq1[tok] * (1.0f / DM) + EPS);
        f32x4 acc0 = {0.f, 0.f, 0.f, 0.f}, acc1 = acc0;
        const float* xr = H1 + (size_t)tok * DM + 8 * fq;
#pragma unroll 2
        for (int ks = 0; ks < 32; ++ks) {
            const f32x4 x0 = *(const f32x4*)(xr + 32 * ks), x1 = *(const f32x4*)(xr + 32 * ks + 4);
            const f32x4 g0 = *(const f32x4*)(gn + 32 * ks + 8 * fq), g1 = *(const f32x4*)(gn + 32 * ks + 8 * fq + 4);
            u32x4 hw, lw; float nv[8]; float xs[8] = {x0[0], x0[1], x0[2], x0[3], x1[0], x1[1], x1[2], x1[3]}; float gs[8] = {g0[0], g0[1], g0[2], g0[3], g1[0], g1[1], g1[2], g1[3]};
#pragma unroll
            for (int q = 0; q < 4; ++q) { const unsigned h = cvt_pk_bf16(xs[2 * q], xs[2 * q + 1]); hw[q] = h;
                lw[q] = cvt_pk_bf16(xs[2 * q] - bflo(h), xs[2 * q + 1] - bfhi(h));
                nv[2 * q] = xs[2 * q] * rstd * gs[2 * q] * 16.0f; nv[2 * q + 1] = xs[2 * q + 1] * rstd * gs[2 * q + 1] * 16.0f; }
            { u32x2 nw; nw.x = cvt_pk4_fp8(nv[0], nv[1], nv[2], nv[3]); nw.y = cvt_pk4_fp8(nv[4], nv[5], nv[6], nv[7]); *(u32x2*)(XN2 + (size_t)tok * DM + 32 * ks + 8 * fq) = nw; }
            const bf16x8 xh = *reinterpret_cast<bf16x8*>(&hw), xl = *reinterpret_cast<bf16x8*>(&lw);
            const bf16x8 wh0 = *(const LAS bf16x8*)(Wh + fr * RW_PITCH + 32 * ks + 8 * fq), wh1 = *(const LAS bf16x8*)(Wh + (16 + fr) * RW_PITCH + 32 * ks + 8 * fq);
            const bf16x8 wl0 = *(const LAS bf16x8*)(Wl + fr * RW_PITCH + 32 * ks + 8 * fq), wl1 = *(const LAS bf16x8*)(Wl + (16 + fr) * RW_PITCH + 32 * ks + 8 * fq);
            acc0 = __builtin_amdgcn_mfma_f32_16x16x32_bf16(xh, wh0, acc0, 0, 0, 0); acc0 = __builtin_amdgcn_mfma_f32_16x16x32_bf16(xl, wh0, acc0, 0, 0, 0); acc0 = __builtin_amdgcn_mfma_f32_16x16x32_bf16(xh, wl0, acc0, 0, 0, 0);
            acc1 = __builtin_amdgcn_mfma_f32_16x16x32_bf16(xh, wh1, acc1, 0, 0, 0); acc1 = __builtin_amdgcn_mfma_f32_16x16x32_bf16(xl, wh1, acc1, 0, 0, 0); acc1 = __builtin_amdgcn_mfma_f32_16x16x32_bf16(xh, wl1, acc1, 0, 0, 0);
        }
#pragma unroll
        for (int r = 0; r < 4; ++r) { lg[(4 * fq + r) * 33 + fr] = acc0[r]; lg[(4 * fq + r) * 33 + 16 + fr] = acc1[r]; }
        LDS_WAIT(); asm volatile("" ::: "memory");
        if (lane < 16) { const int tk = tok0 + lane; const float rs = __builtin_amdgcn_rsqf(ssq1[tk] * (1.0f / DM) + EPS);
            float v[32];
#pragma unroll
            for (int e = 0; e < 32; ++e) v[e] = lg[lane * 33 + e] * rs + br[e];
            int bi4[4]; float bv4[4];
#pragma unroll
            for (int k = 0; k < 4; ++k) { float bv = -INFINITY; int be = 0;
#pragma unroll
                for (int e = 0; e < 32; ++e) { const bool tk_ = v[e] > bv; bv = tk_ ? v[e] : bv; be = tk_ ? e : be; }
                bi4[k] = be; bv4[k] = bv;
#pragma unroll
                for (int e = 0; e < 32; ++e) v[e] = (e == be) ? -INFINITY : v[e]; }
            const float e1 = __expf(bv4[1] - bv4[0]), e2 = __expf(bv4[2] - bv4[0]), e3 = __expf(bv4[3] - bv4[0]); const float inv = 1.0f / (1.0f + e1 + e2 + e3);
            const float gw[4] = {inv, e1 * inv, e2 * inv, e3 * inv};
            *(f32x4*)(GATEW + (size_t)tk * 4) = (f32x4){gw[0], gw[1], gw[2], gw[3]};
#pragma unroll
            for (int k = 0; k < 4; ++k) { const int pos = atomicAdd((int*)(lcount + bi4[k]), 1); const int n = (wave * 16 + lane) * 4 + k; lent[n] = (bi4[k] << 20) | pos; } }
        __syncthreads();
        if (tid < 32) { lbase[tid] = (int)__hip_atomic_fetch_add(gcount + 64 * tid, (unsigned)lcount[tid], __ATOMIC_RELAXED, __HIP_MEMORY_SCOPE_AGENT); }
        __syncthreads();
        { const int en = lent[tid], e = en >> 20, pos = en & 0xfffff; LIST[(size_t)e * NTOK + lbase[e] + pos] = bi * 512 + tid; }
        __syncthreads();
        if (tid < 32) lcount[tid] = 0;
        __syncthreads();
    }
}

__device__ __forceinline__ int moe_table(const Args& a, LAS unsigned char* lds) {
    LAS int* tab = (LAS int*)(lds + LDS_TAB); const unsigned* gcount = (const unsigned*)(a.ws + WS_CTL) + CW_CNT;
    if (threadIdx.x == 0) { int T = 0;
        for (int e = 0; e < NEXP; ++e) { const int cnt = (int)__hip_atomic_load(gcount + 64 * e, __ATOMIC_RELAXED, __HIP_MEMORY_SCOPE_AGENT);
            for (int r0 = 0; r0 < cnt; r0 += 256) { const int v = cnt - r0 < 256 ? cnt - r0 : 256; tab[2 * T] = e | (v << 8); tab[2 * T + 1] = r0; ++T; } }
        tab[2 * MAXTILES] = T; }
    __syncthreads();
    return tab[2 * MAXTILES];
}

__device__ __forceinline__ void p10_combine(const Args& a, int vcu, int G) {
    const int tid = threadIdx.x, lane = tid & 63, wave = __builtin_amdgcn_readfirstlane(tid >> 6); unsigned char* ws = a.ws; const int gw = vcu * 8 + wave, NGW = G * 8;
    float* H1 = (float*)(ws + WS_H1); const bf16_t* YS = (const bf16_t*)(ws + WS_YS); bf16_t* XN3 = (bf16_t*)(ws + WS_XN3); const float* g = a.in[22];
    f32x4 gv[4];
#pragma unroll
    for (int j = 0; j < 4; ++j) gv[j] = *(const f32x4*)(g + 4 * lane + 256 * j);
    for (int m0 = gw * 2; m0 < NTOK; m0 += NGW * 2) {
        f32x4 v[2][4]; u32x2 w[2][4][4];
#pragma unroll
        for (int r = 0; r < 2; ++r)
#pragma unroll
            for (int j = 0; j < 4; ++j) { v[r][j] = ((const f32x4*)(H1 + (size_t)(m0 + r) * DM) + lane)[64 * j];
#pragma unroll
                for (int k = 0; k < 4; ++k) w[r][j][k] = *((const u32x2*)(YS + ((size_t)(m0 + r) * 4 + k) * DM) + lane + 64 * j); }
#pragma unroll
        for (int r = 0; r < 2; ++r) { float s = 0.f; f32x4* hr = (f32x4*)(H1 + (size_t)(m0 + r) * DM) + lane;
#pragma unroll
            for (int j = 0; j < 4; ++j) {
#pragma unroll
                for (int k = 0; k < 4; ++k) { v[r][j][0] += bflo(w[r][j][k].x); v[r][j][1] += bfhi(w[r][j][k].x); v[r][j][2] += bflo(w[r][j][k].y); v[r][j][3] += bfhi(w[r][j][k].y); }
                hr[64 * j] = v[r][j]; s += (v[r][j][0] * v[r][j][0] + v[r][j][1] * v[r][j][1]) + (v[r][j][2] * v[r][j][2] + v[r][j][3] * v[r][j][3]); }
            const float rstd = __builtin_amdgcn_rsqf(wave_sum(s) * (1.0f / DM) + EPS);
            u32x2* o8 = (u32x2*)(XN3 + (size_t)(m0 + r) * DM) + lane;
#pragma unroll
            for (int j = 0; j < 4; ++j) { u32x2 o; o.x = cvt_pk_bf16(v[r][j][0] * rstd * gv[j][0], v[r][j][1] * rstd * gv[j][1]); o.y = cvt_pk_bf16(v[r][j][2] * rstd * gv[j][2], v[r][j][3] * rstd * gv[j][3]); o8[64 * j] = o; } } }
}
__device__ __forceinline__ void p12_final(const Args& a, int vcu, int G) {
    const int tid = threadIdx.x, lane = tid & 63, wave = __builtin_amdgcn_readfirstlane(tid >> 6); unsigned char* ws = a.ws; const int gw = vcu * 8 + wave, NGW = G * 8;
    const float* ssq3 = (const float*)(ws + CTLB_SSQ3); const float* g = a.in[25];
    f32x4 gv[4];
#pragma unroll
    for (int j = 0; j < 4; ++j) gv[j] = *(const f32x4*)(g + 4 * lane + 256 * j);
    for (int m0 = gw * 4; m0 < NTOK; m0 += NGW * 4) { f32x4 v[4][4]; float rs[4];
#pragma unroll
        for (int r = 0; r < 4; ++r) { rs[r] = __builtin_amdgcn_rsqf(ssq3[m0 + r] * (1.0f / DM) + EPS);
#pragma unroll
            for (int j = 0; j < 4; ++j) v[r][j] = ((const f32x4*)(a.out + (size_t)(m0 + r) * DM) + lane)[64 * j]; }
#pragma unroll
        for (int r = 0; r < 4; ++r)
#pragma unroll
            for (int j = 0; j < 4; ++j) ((f32x4*)(a.out + (size_t)(m0 + r) * DM) + lane)[64 * j] = v[r][j] * rs[r] * gv[j]; }
}

__global__ void __launch_bounds__(512, 2) fwd_kernel(Args a) {
    extern __shared__ __attribute__((aligned(16))) unsigned char lds_raw[];
    LAS unsigned char* lds = (LAS unsigned char*)lds_raw;
    const int tid = threadIdx.x;
    const int G = gridDim.x; const int bx = blockIdx.x; const int vcu = (G % 8 == 0) ? (bx % 8) * (G / 8) + bx / 8 : bx;
    unsigned char* ws = a.ws;
    volatile LAS unsigned* MISC = (volatile LAS unsigned*)(lds + LDS_MISC);
    if (tid < 64) MISC[tid] = 0u;
    __syncthreads();
    unsigned* ctl = (unsigned*)(ws + WS_CTL);
    XcdBarrier bar; bar.bar = ctl + CW_BAR; bar.x = 0; bar.st = nullptr;
    if (MK_ONE_LAUNCH) bar = xcd_barrier_post(ctl + CW_BAR, MISC + 8);
    const int lo = a.ph_lo, hi = a.ph_hi;
#ifndef PHASE_MASK
#define PHASE_MASK 0x1fff
#endif
#define IN(k) (((PHASE_MASK >> (k)) & 1) && lo <= (k) && (k) < hi)
#define SEAM(k) do { if (IN(k) && IN((k) + 1)) xcd_barrier(bar); } while (0)

    bf16_t* U = (bf16_t*)(ws + WS_U); bf16_t* XN = (bf16_t*)(ws + WS_XN); bf16_t* Q = (bf16_t*)(ws + WS_Q); bf16_t* KV = (bf16_t*)(ws + WS_KV);
    bf16_t* Y = (bf16_t*)(ws + WS_Y); float* H1 = (float*)(ws + WS_H1);

    if (IN(0)) { for (int dup = 0; dup < (PROBE_DUP == 1 ? 2 : 1); ++dup) p0_prologue(a, lds, vcu, G); } SEAM(0);

    if (IN(1)) {
        ProbBf16<false> p; p.Abase = (const char*)XN; p.lda = DM; p.Bt = (const bf16_t*)(ws + WS_WIN); p.ldb = DM; p.K = DM; p.tmid = 0; p.S.init(128, 10, G, bx);
        p.O = U; p.ldc = NU; p.rope_pn = -1; p.cs = nullptr;
        for (int dup = 0; dup < (PROBE_DUP == 2 ? 2 : 1); ++dup) pg8::gemm_phase(lds, p);
    } SEAM(1);

    if (IN(2)) { p2_tail(a, vcu, G); } SEAM(2);

    if (IN(3)) {
        for (int dup = 0; dup < (PROBE_DUP == 3 ? 2 : 1); ++dup) {
        { ProbBf16<true> p; p.Abase = (const char*)(U + UC_CQ); p.lda = NU; p.Bt = (const bf16_t*)(ws + WS_WQ); p.ldb = 256; p.K = 256; p.tmid = 0; p.S.init(128, 3, G, bx);
          p.O = Q; p.ldc = 768; p.rope_pn = 2; p.cs = (const float*)(ws + WS_CS); pg8::gemm_phase(lds, p); }
        { ProbBf16<false> p; p.Abase = (const char*)(U + UC_CKV); p.lda = NU; p.Bt = (const bf16_t*)(ws + WS_WKV); p.ldb = 256; p.K = 256; p.tmid = 0; p.S.init(128, 4, G, bx);
          p.O = KV; p.ldc = 1024; p.rope_pn = -1; p.cs = nullptr; pg8::gemm_phase(lds, p); }
        { ProbBf16<false> p; p.Abase = (const char*)(ws + WS_PB); p.lda = 256; p.Bt = (const bf16_t*)(ws + WS_WPP); p.ldb = 256; p.K = 256; p.tmid = 0; p.S.init(128, 4, G, bx);
          p.O = (bf16_t*)(ws + WS_PP); p.ldc = 1024; p.rope_pn = -1; p.cs = nullptr; pg8::gemm_phase(lds, p); }
        }
        for (int dup = 0; dup < (PROBE_DUP == 4 ? 2 : 1); ++dup)
        for (int u = vcu; u < 1024; u += G) mlstm_local(a, lds, u);
    } SEAM(3);

    if (IN(4)) { mlstm_scan(a, vcu, G); } SEAM(4);

    if (IN(5)) {
        for (int dup = 0; dup < (PROBE_DUP == 5 ? 2 : 1); ++dup)
        for (int u = vcu; u < 512; u += G) {
            const int qb = u & 15, bh = u >> 4, h = bh & 3, b = bh >> 2; const size_t t0 = (size_t)b * SEQ;
            att::attn_unit(Q + (t0 + qb * 256) * 768 + h * 128, Q + (t0 + qb * 256) * 768 + 512 + h * 64, KV + t0 * 1024 + h * 128, KV + t0 * 1024 + 512 + h * 128,
                           (const bf16_t*)(ws + WS_KPE) + t0 * 64, Y + (t0 + qb * 256) * DM + h * 128, (float*)(ws + CTLB_SSQO) + t0 + qb * 256, dup ? 0.f : 1.f, SEQ, lds);
        }
        for (int dup = 0; dup < (PROBE_DUP == 6 ? 2 : 1); ++dup)
        for (int u = vcu; u < 1024; u += G) mlstm_out(a, lds, u);
    } SEAM(5);

    if (IN(6)) {
        ProbWout p; p.Abase = (const char*)Y; p.lda = DM; p.Bt = (const bf16_t*)(ws + WS_WOUT); p.ldb = DM; p.K = DM; p.tmid = 8; p.S.init(128, 4, G, bx);
        p.x = a.in[0]; p.H1 = H1; p.ssqo = (const float*)(ws + CTLB_SSQO); p.ssq1 = (float*)(ws + CTLB_SSQ1);
        for (int dup = 0; dup < (PROBE_DUP == 7 ? 2 : 1); ++dup) { p.sqs = dup ? 0.f : 1.f; pg8::gemm_phase(lds, p); }
    } SEAM(6);

    if (IN(7)) { p7_router(a, lds, vcu, G); } SEAM(7);

    if (IN(8)) {
        const int T = moe_table(a, lds);
        ProbMoe1 p; p.Abase = (const char*)XN; p.Wgu = ws + WS_WGU; p.ldb = 512; p.K = 512; p.tmid = 0;
        p.S.tab = (const LAS int*)(lds + LDS_TAB); p.S.T = T; p.S.nN = 8; p.S.G = G; p.S.c = bx;
        p.list = (const int*)(ws + WS_LIST); p.bgu = a.in[19]; p.HMID = ws + WS_HMID;
        for (int dup = 0; dup < (PROBE_DUP == 8 ? 2 : 1); ++dup) pg8::gemm_phase(lds, p);
    } SEAM(8);

    if (IN(9)) {
        const int T = moe_table(a, lds);
        ProbMoe2 p; p.Abase = (const char*)(ws + WS_HMID); p.Wdn = ws + WS_WDN; p.ldb = 512; p.K = 512; p.tmid = 0;
        p.S.tab = (const LAS int*)(lds + LDS_TAB); p.S.T = T; p.S.nN = 4; p.S.G = G; p.S.c = bx;
        p.list = (const int*)(ws + WS_LIST); p.bdn = a.in[21]; p.gatew = (const float*)(ws + WS_GATEW); p.YS = (bf16_t*)(ws + WS_YS);
        for (int dup = 0; dup < (PROBE_DUP == 9 ? 2 : 1); ++dup) pg8::gemm_phase(lds, p);
    } SEAM(9);

    if (IN(10)) { p10_combine(a, vcu, G); } SEAM(10);

    if (IN(11)) {
        ProbPle p; p.Abase = (const char*)(ws + WS_XN3); p.lda = DM; p.Bt = (const bf16_t*)(ws + WS_WPG); p.ldb = DM; p.K = DM; p.tmid = 0; p.S.init(128, 4, G, bx);
        p.H2 = H1; p.PP = (const bf16_t*)(ws + WS_PP); p.out = a.out; p.ssq3 = (float*)(ws + CTLB_SSQ3);
        for (int dup = 0; dup < (PROBE_DUP == 10 ? 2 : 1); ++dup) { p.sqs = dup ? 0.f : 1.f; pg8::gemm_phase(lds, p); }
    } SEAM(11);

    if (IN(12)) { p12_final(a, vcu, G); }
#undef IN
#undef SEAM
}

extern "C" void kernel_launch(void* const* d_in, const int* in_sizes, int n_in, void* d_out, int out_size, void* d_ws, size_t ws_size, hipStream_t stream) {
    static int grid = 0;
    if (grid == 0) {
        if (n_in != 26 || in_sizes[0] != NTOK * DM || out_size != NTOK * DM || ws_size < WS_END) {
            fprintf(stderr, "kernel_launch: unexpected shapes: n_in %d in0 %d out %d ws %zu (need %zu)\n", n_in, n_in > 0 ? in_sizes[0] : -1, out_size, ws_size, (size_t)WS_END); grid = -1; return; }
        int dev = 0, cus = 0, per_cu = 0;
        if (hipGetDevice(&dev) != hipSuccess || hipDeviceGetAttribute(&cus, hipDeviceAttributeMultiprocessorCount, dev) != hipSuccess) { grid = -1; return; }
        if (hipFuncSetAttribute((const void*)fwd_kernel, hipFuncAttributeMaxDynamicSharedMemorySize, LDS_BYTES) != hipSuccess) { fprintf(stderr, "kernel_launch: hipFuncSetAttribute failed\n"); grid = -1; return; }
        if (hipOccupancyMaxActiveBlocksPerMultiprocessor(&per_cu, (const void*)fwd_kernel, 512, LDS_BYTES) != hipSuccess || per_cu < 1) { fprintf(stderr, "kernel_launch: occupancy query says %d\n", per_cu); }
        (void)hipGetLastError();
        grid = cus - (cus % 8);
        if (grid <= 0) grid = 8;
    }
    if (grid < 0) return;
    (void)hipMemsetAsync((char*)d_ws + WS_CTL, 0, CTL_ZERO_BYTES, stream);
    Args a{};
    for (int i = 0; i < 26; ++i) a.in[i] = (const float*)d_in[i];
    a.out = (float*)d_out; a.ws = (unsigned char*)d_ws;
#if MK_ONE_LAUNCH
    a.ph_lo = 0; a.ph_hi = NPHASE;
    hipLaunchKernelGGL(fwd_kernel, dim3(grid), dim3(512), LDS_BYTES, stream, a);
#else
    for (int ph = 0; ph < NPHASE; ++ph) { a.ph_lo = ph; a.ph_hi = ph + 1; hipLaunchKernelGGL(fwd_kernel, dim3(grid), dim3(512), LDS_BYTES, stream, a); }
#endif
    const hipError_t le = hipPeekAtLastError();
    if (le != hipSuccess) fprintf(stderr, "kernel_launch: launch failed: %s\n", hipGetErrorName(le));
}
```

```cpp
#include <hip/hip_runtime.h>
#include <cstdio>
#include <cstdint>

#ifndef PROBE_DUP
#define PROBE_DUP 0
#endif
#ifndef PROBE_TIME
#define PROBE_TIME 0
#endif
#ifndef DBG_MODE
#define DBG_MODE 0
#endif
#ifndef MK_ONE_LAUNCH
#define MK_ONE_LAUNCH 1
#endif

#define LAS __attribute__((address_space(3)))
#define GAS __attribute__((address_space(1)))
typedef unsigned short bf16_t;
typedef short bf16x8 __attribute__((ext_vector_type(8)));
typedef short s16x4 __attribute__((ext_vector_type(4)));
typedef float f32x2 __attribute__((ext_vector_type(2)));
typedef float f32x4 __attribute__((ext_vector_type(4)));
typedef float f32x16 __attribute__((ext_vector_type(16)));
typedef unsigned u32x2 __attribute__((ext_vector_type(2)));
typedef unsigned u32x4 __attribute__((ext_vector_type(4)));
typedef long i64x2 __attribute__((ext_vector_type(2)));
typedef int i32x4 __attribute__((ext_vector_type(4)));
typedef int i32x8 __attribute__((ext_vector_type(8)));

constexpr int NTOK = 32768, DM = 1024, SEQ = 4096, NBATCH = 8;
constexpr int NU = 2560;
constexpr int UC_Q = 0, UC_K = 512, UC_V = 1024, UC_O = 1536, UC_CQ = 2048, UC_CKV = 2304, UC_KR = 2432, UC_G = 2496;
constexpr int NEXP = 32, TOPK = 4, NSLOT = NTOK * TOPK;
constexpr int MAXTILES = 544;
constexpr float EPS = 1e-6f;
constexpr int NPHASE = 13;

constexpr size_t MiB = 1u << 20;
constexpr size_t WS_CTL = 0, CTL_ZERO_BYTES = 1 * MiB;
constexpr size_t CTLB_SSQO = 128 * 1024, CTLB_SSQ1 = 256 * 1024, CTLB_SSQ3 = 384 * 1024;
constexpr size_t WS_WIN = 1 * MiB, WS_WQ = 6 * MiB, WS_WKV = 6 * MiB + 512 * 1024, WS_WOUT = 7 * MiB, WS_WPG = 9 * MiB, WS_WPP = 11 * MiB;
constexpr size_t WS_WGU = 12 * MiB, WS_WDN = 140 * MiB;
constexpr size_t WS_CS = 204 * MiB, WS_G = 212 * MiB, WS_KPE = 214 * MiB, WS_GATEW = 218 * MiB, WS_LIST = 219 * MiB, WS_LOCN = 223 * MiB, WS_MSC = 224 * MiB, WS_PB = 225 * MiB;
constexpr size_t WS_TOPI = 224 * MiB + 512 * 1024;
constexpr size_t WS_XN = 242 * MiB, WS_LOCC = 306 * MiB, WS_Y = 370 * MiB, WS_YS = 242 * MiB;
constexpr size_t WS_U = 498 * MiB, WS_Q = 658 * MiB, WS_KV = 706 * MiB, WS_HMID = 498 * MiB, WS_XN3 = 498 * MiB;
constexpr size_t WS_H1 = 770 * MiB, WS_PP = 898 * MiB, WS_END = 962 * MiB;
constexpr int CW_TMO = 0, CW_BAR = 4096, CW_CNT = 8192;

constexpr int RING_BYTES = 131072;
constexpr int LDS_TAB = 147456;
constexpr int LDS_MISC = LDS_TAB + 4608;
constexpr int LDS_WTAB = LDS_MISC + 256;
constexpr int LDS_BYTES = LDS_WTAB + 256;

__device__ __forceinline__ int lane_id() { return (int)__builtin_amdgcn_mbcnt_hi(~0u, __builtin_amdgcn_mbcnt_lo(~0u, 0u)); }
__device__ __forceinline__ int hw_wave_key() { return (int)(__builtin_amdgcn_s_getreg((5 << 11) | 4) & 63u); }
__device__ __forceinline__ int wave_id() { return __builtin_amdgcn_readfirstlane(*(volatile LAS int*)(unsigned long)(LDS_WTAB + 4 * hw_wave_key())); }
__device__ __forceinline__ int tid_x() { return wave_id() * 64 + lane_id(); }
#define LDS_WAIT() asm volatile("s_waitcnt lgkmcnt(0)" ::: "memory")
#define VM_WAIT() asm volatile("s_waitcnt vmcnt(0)" ::: "memory")
#define SBAR() __builtin_amdgcn_sched_barrier(0)
__device__ __forceinline__ float bf2f(bf16_t x) { return __uint_as_float((unsigned)x << 16); }
__device__ __forceinline__ float bflo(unsigned w) { return __uint_as_float(w << 16); }
__device__ __forceinline__ float bfhi(unsigned w) { return __uint_as_float(w & 0xffff0000u); }
typedef __bf16 bf16x2n __attribute__((ext_vector_type(2)));
__device__ __forceinline__ unsigned cvt_pk_bf16(float lo, float hi) { const f32x2 v = {lo, hi}; return __builtin_bit_cast(unsigned, __builtin_convertvector(v, bf16x2n)); }
__device__ __forceinline__ unsigned cvt_pk4_fp8(float a, float b, float c, float d) {
    a = fminf(fmaxf(a, -448.f), 448.f); b = fminf(fmaxf(b, -448.f), 448.f); c = fminf(fmaxf(c, -448.f), 448.f); d = fminf(fmaxf(d, -448.f), 448.f);
    int w = 0; w = __builtin_amdgcn_cvt_pk_fp8_f32(a, b, w, false); w = __builtin_amdgcn_cvt_pk_fp8_f32(c, d, w, true); return (unsigned)w; }
__device__ __forceinline__ float wave_sum(float v) {
#pragma unroll
    for (int o = 1; o < 64; o <<= 1) v += __shfl_xor(v, o);
    return v;
}
__device__ __forceinline__ float fast_exp(float x) { return __builtin_amdgcn_exp2f(x * 1.4426950408889634f); }
__device__ __forceinline__ float sigmoid_f(float x) { return __builtin_amdgcn_rcpf(1.0f + fast_exp(-x)); }

struct Args {
    const float* in[26];
    float* out;
    unsigned char* ws;
    int ph_lo, ph_hi;
};
#define CARGS const __attribute__((address_space(4))) Args
__device__ __forceinline__ CARGS* arg_ptr() { CARGS* p = (CARGS*)__builtin_amdgcn_kernarg_segment_ptr(); asm volatile("" : "+s"(p)); return p; }

#define XB_TMO      128
#define XB_XCNT(j)  (256  + 64 * (j))
#define XB_XSUB(j)  (1280 + 64 * (j))
#define XB_XGEN(j)  (2304 + 64 * (j))
#define XB_TOP      3328
#define XB_TOPGEN   3392
#define XCD_BAR_WORDS 3456
#define XB_SPIN_CAP (1u << 20)

__device__ __forceinline__ unsigned xb_ld(unsigned* p)              { return __hip_atomic_load(p, __ATOMIC_RELAXED, __HIP_MEMORY_SCOPE_AGENT); }
__device__ __forceinline__ unsigned xb_add(unsigned* p, unsigned v) { return __hip_atomic_fetch_add(p, v, __ATOMIC_RELAXED, __HIP_MEMORY_SCOPE_AGENT); }
__device__ __forceinline__ unsigned xb_xcc_id() { return (unsigned)__builtin_amdgcn_s_getreg((3 << 11) | 20) & 0xFu; }
#define XB_SPIN(cond, bar) do { unsigned _sp = 0; while (cond) { __builtin_amdgcn_s_sleep(1); \
    if ((++_sp & 255u) == 0u) { if (xb_ld(&(bar)[XB_TMO])) break; if (_sp > XB_SPIN_CAP) { atomicAdd(&(bar)[XB_TMO], 1u); break; } } } } while (0)

struct XcdBarrier { unsigned* bar; unsigned x; volatile LAS unsigned* st; };

__device__ __forceinline__ XcdBarrier xcd_barrier_post(unsigned* bar, volatile LAS unsigned* st) {
    XcdBarrier b; b.bar = bar; b.x = xb_xcc_id(); b.st = st;
    if (tid_x() == 0) (void)xb_add(&bar[XB_XCNT(b.x)], 1u);
    return b;
}
__device__ __forceinline__ void xcd_barrier_complete(unsigned* bar, unsigned x, unsigned& nloc, unsigned& nx) {
    const unsigned G = gridDim.x * gridDim.y * gridDim.z;
    unsigned sum, cnt, mine, sp = 0u;
    for (;;) {
        sum = 0u; cnt = 0u; mine = 0u;
#pragma unroll
        for (unsigned j = 0; j < 16; ++j) { const unsigned c = xb_ld(&bar[XB_XCNT(j)]); sum += c; cnt += (c > 0u) ? 1u : 0u; mine = (j == x) ? c : mine; }
        if (sum == G) break;
        __builtin_amdgcn_s_sleep(1);
        if ((++sp & 255u) == 0u) { if (xb_ld(&bar[XB_TMO])) break; if (sp > XB_SPIN_CAP) { atomicAdd(&bar[XB_TMO], 1u); break; } }
    }
    nloc = mine > 0u ? mine : 1u; nx = cnt > 0u ? cnt : 1u;
}
__device__ __forceinline__ void xcd_barrier(const XcdBarrier& b) {
    asm volatile("s_waitcnt vmcnt(0)" ::: "memory");
    __syncthreads();
    if (tid_x() == 0) {
        unsigned* bar = b.bar;
        __builtin_amdgcn_s_waitcnt(0);
        unsigned nloc = b.st[0], nx = b.st[1];
        if (nloc == 0u) { xcd_barrier_complete(bar, b.x, nloc, nx); b.st[0] = nloc; b.st[1] = nx; }
        const unsigned old = xb_add(&bar[XB_XSUB(b.x)], 1u);
        const unsigned gen = old / nloc;
        if (old + 1u == (gen + 1u) * nloc) {
            __builtin_amdgcn_fence(__ATOMIC_RELEASE, "agent");
            asm volatile("s_waitcnt vmcnt(0)" ::: "memory");
            const unsigned og = xb_add(&bar[XB_TOP], 1u);
            const unsigned tg = og / nx;
            if (og + 1u == (tg + 1u) * nx) xb_add(&bar[XB_TOPGEN], 1u);
            else XB_SPIN(xb_ld(&bar[XB_TOPGEN]) == tg, bar);
            __builtin_amdgcn_fence(__ATOMIC_ACQUIRE, "agent");
            xb_add(&bar[XB_XGEN(b.x)], 1u);
            asm volatile("s_waitcnt vmcnt(0)" ::: "memory");
        } else {
            XB_SPIN(xb_ld(&bar[XB_XGEN(b.x)]) == gen, bar);
            __builtin_amdgcn_fence(__ATOMIC_ACQUIRE, "agent");
            asm volatile("s_waitcnt vmcnt(0)" ::: "memory");
        }
    }
    __syncthreads();
}

namespace pg8 {
constexpr int BM = 256, BK = 64, HALF = 128, HTB = HALF * BK * 2, STAGE_BYTES = 8 * HTB, NXCD = 8, WGM = 8;
__host__ __device__ __forceinline__ int lds_byte(int r, int c) { const int st = (r >> 4) * 2 + (c >> 5), rr = r & 15, cc = c & 31, ob = rr * 64 + cc * 2; return st * 1024 + (ob ^ (((ob >> 9) & 1) << 5)); }
__host__ __device__ __forceinline__ void stage_rc(int b, int& R, int& C) { const int st = b / 1024, sb = b % 1024, swz = sb ^ (((sb >> 9) & 1) << 5); R = (st >> 1) * 16 + swz / 64; C = (st & 1) * 32 + (swz % 64) / 2; }
__host__ __device__ __forceinline__ int perm32(int rho) { const int n = rho >> 4, i = rho & 15; return 8 * (i >> 2) + 4 * n + (i & 3); }

struct Unit { int pm, pn; };
typedef f32x4 Acc[2][2][4][2];
template <bool F8> struct FragSel { typedef bf16x8 T; static constexpr int NK = 2; };
template <> struct FragSel<true> { typedef i32x8 T; static constexpr int NK = 1; };

struct StaticOrder {
    int nM, nN, nwg, G, c;
    __device__ void init(int nM_, int nN_, int G_, int c_) { nM = nM_; nN = nN_; nwg = nM * nN; G = G_; c = c_; }
    __device__ __forceinline__ bool next(int i, Unit& u) const {
        const long L = (long)i * G + c; if (L >= nwg) return false;
        int wgid = (int)L; { const int q = nwg / NXCD, r = nwg % NXCD, xcd = wgid % NXCD, off = wgid / NXCD; wgid = (xcd < r ? xcd * (q + 1) : r * (q + 1) + (xcd - r) * q) + off; }
        const int nig = WGM * nN, gid = wgid / nig, fm = gid * WGM, gsz = (nM - fm) < WGM ? (nM - fm) : WGM;
        u.pm = fm + ((wgid % nig) % gsz); u.pn = (wgid % nig) / gsz; return true;
    }
};

template <class P>
__device__ __forceinline__ void gemm_phase(LAS unsigned char* lds, const P& p) {
    const int tid = tid_x(), wid = __builtin_amdgcn_readfirstlane(tid >> 6), lane = tid & 63, wr = wid >> 2, wc = wid & 3, fr = lane & 15, fq = lane >> 4;
    const int nt = p.K / BK;
    int Rr[2]; unsigned cA2[2], voffB[2];
#pragma unroll
    for (int i = 0; i < 2; ++i) { int R, C; stage_rc(tid * 16 + i * 8192, R, C); const int Rb = P::PERM ? ((R & ~31) + perm32(R & 31)) : R;
        Rr[i] = R; cA2[i] = (unsigned)C * 2u; voffB[i] = (unsigned)(Rb * p.ldb + C) * 2u; }
    const size_t kstep = (size_t)(BK * 2);
    const size_t hstepB = (size_t)HALF * p.ldb * 2;
    const unsigned ldsw = (unsigned)wid * 1024u;
    const int aoff = lds_byte(wr * 64 + fr, fq * 8), boff = lds_byte(wc * 32 + fr, fq * 8);
#define PG8_SA(b, h) (((b) * 2 + (h)) * HTB)
#define PG8_SB(b, h) ((4 + (b) * 2 + (h)) * HTB)
#define PG8_STAGE_B(bufoff, gbase) do { _Pragma("unroll") for (int _i = 0; _i < 2; ++_i) \
        __builtin_amdgcn_global_load_lds((const unsigned*)((const char*)(gbase) + voffB[_i]), (LAS unsigned*)(lds + (bufoff) + ldsw + _i * 8192), 16, 0, 0); } while (0)
#define PG8_STAGE_A(bufoff, ab, kb, v0, v1) do { \
        __builtin_amdgcn_global_load_lds((const unsigned*)((ab) + (kb) + (v0)), (LAS unsigned*)(lds + (bufoff) + ldsw), 16, 0, 0); \
        __builtin_amdgcn_global_load_lds((const unsigned*)((ab) + (kb) + (v1)), (LAS unsigned*)(lds + (bufoff) + ldsw + 8192), 16, 0, 0); } while (0)
#define PG8_LD16(off) (*(const LAS i32x4*)(lds + (off)))
#define PG8_LDA(dst, b, h) do { _Pragma("unroll") for (int m = 0; m < 4; ++m) { if constexpr (P::FP8) dst[m][0] = __builtin_shufflevector(PG8_LD16(PG8_SA(b, h) + aoff + m * 2048), PG8_LD16(PG8_SA(b, h) + aoff + m * 2048 + 1024), 0, 1, 2, 3, 4, 5, 6, 7); \
        else { _Pragma("unroll") for (int k = 0; k < NK; ++k) dst[m][k] = __builtin_bit_cast(Frag, PG8_LD16(PG8_SA(b, h) + aoff + m * 2048 + k * 1024)); } } } while (0)
#define PG8_LDB(dst, b, h) do { _Pragma("unroll") for (int n = 0; n < 2; ++n) { if constexpr (P::FP8) dst[n][0] = __builtin_shufflevector(PG8_LD16(PG8_SB(b, h) + boff + n * 2048), PG8_LD16(PG8_SB(b, h) + boff + n * 2048 + 1024), 0, 1, 2, 3, 4, 5, 6, 7); \
        else { _Pragma("unroll") for (int k = 0; k < NK; ++k) dst[n][k] = __builtin_bit_cast(Frag, PG8_LD16(PG8_SB(b, h) + boff + n * 2048 + k * 1024)); } } } while (0)
#define PG8_MMA(ai, bj, At, Bt) do { __builtin_amdgcn_s_setprio(1); \
        if constexpr (P::FP8) { _Pragma("unroll") for (int m = 0; m < 4; ++m) _Pragma("unroll") for (int n = 0; n < 2; ++n) \
            asm volatile("v_mfma_scale_f32_16x16x128_f8f6f4 %0, %1, %2, %0, %3, %3 op_sel_hi:[0,0,0]" : "+v"(acc[ai][bj][m][n]) : "v"(Bt[n][0]), "v"(At[m][0]), "v"(one8)); } \
        else { _Pragma("unroll") for (int m = 0; m < 4; ++m) _Pragma("unroll") for (int n = 0; n < 2; ++n) _Pragma("unroll") for (int k = 0; k < NK; ++k) \
            acc[ai][bj][m][n] = __builtin_amdgcn_mfma_f32_16x16x32_bf16(Bt[n][k], At[m][k], acc[ai][bj][m][n], 0, 0, 0); } __builtin_amdgcn_s_setprio(0); } while (0)
#define PG8_WAIT_V(n) asm volatile("s_waitcnt vmcnt(" #n ")" ::: "memory")
#define PG8_WAIT_L(n) asm volatile("s_waitcnt lgkmcnt(" #n ")" ::: "memory")
#define PG8_BAR __builtin_amdgcn_s_barrier()
#define PG8_SCHED __builtin_amdgcn_sched_barrier(0)
    Unit cur, nxt; int ui = 0;
    if (!p.next(0, cur)) return;
    Acc acc;
#pragma unroll
    for (int a = 0; a < 2; ++a)
#pragma unroll
        for (int b = 0; b < 2; ++b)
#pragma unroll
            for (int m = 0; m < 4; ++m)
#pragma unroll
                for (int n = 0; n < 2; ++n) acc[a][b][m][n] = (f32x4){0.f, 0.f, 0.f, 0.f};
    typedef typename FragSel<P::FP8>::T Frag; constexpr int NK = FragSel<P::FP8>::NK;
    Frag At[4][NK], B0[2][NK], B1[2][NK];
    const int one8 = 0x7f7f7f7f;
    unsigned vc00 = p.a_row_off(cur, Rr[0]) + cA2[0], vc01 = p.a_row_off(cur, Rr[1]) + cA2[1];
    unsigned vc10 = p.a_row_off(cur, HALF + Rr[0]) + cA2[0], vc11 = p.a_row_off(cur, HALF + Rr[1]) + cA2[1];
    const char* cB = p.b_tile(cur);
    const char* Ab = p.a_base(cur);
    PG8_STAGE_B(PG8_SB(0, 0), cB); PG8_STAGE_B(PG8_SB(0, 1), cB + hstepB); PG8_STAGE_A(PG8_SA(0, 0), Ab, 0, vc00, vc01); PG8_STAGE_A(PG8_SA(0, 1), Ab, 0, vc10, vc11);
    if (wr == 1) PG8_BAR;
    PG8_WAIT_V(2); PG8_BAR;
    PG8_STAGE_B(PG8_SB(1, 0), cB + kstep); PG8_STAGE_A(PG8_SA(1, 0), Ab, kstep, vc00, vc01); PG8_STAGE_B(PG8_SB(1, 1), cB + hstepB + kstep);
    PG8_WAIT_V(6); PG8_BAR;
    const int tload = nt >= 4 ? nt - 4 : 0;
    unsigned long long tk_ = 0, te_ = 0, tm_ = PROBE_TIME ? wall_clock64() : 0;
    for (;;) {
        const bool has_next = p.next(ui + 1, nxt);
        unsigned vn00 = vc00, vn01 = vc01, vn10 = vc10, vn11 = vc11;
        const char* nB = has_next ? p.b_tile(nxt) : cB;
        const char* nAb = has_next ? p.a_base(nxt) : Ab;
#pragma unroll 1
        for (int t = 0; t < nt; t += 2) {
            const bool last = (t == nt - 2);
            if constexpr (P::GATHER) { if (t == tload && has_next) {
                vn00 = p.a_row_off(nxt, Rr[0]) + cA2[0]; vn01 = p.a_row_off(nxt, Rr[1]) + cA2[1];
                vn10 = p.a_row_off(nxt, HALF + Rr[0]) + cA2[0]; vn11 = p.a_row_off(nxt, HALF + Rr[1]) + cA2[1]; } }
            if (p.tmid > 0 && t == p.tmid) p.mid(acc, cur, wr, wc, fr, fq);
            const size_t k1 = (size_t)(t + 1) * kstep, k2 = last ? 0 : (size_t)(t + 2) * kstep, k3 = k2 + kstep;
            const char* b2 = last ? nB : cB + (size_t)(t + 2) * kstep; const char* b3 = b2 + kstep;
            const char* a2 = last ? nAb : Ab;
            unsigned v200 = vc00, v201 = vc01, v210 = vc10, v211 = vc11;
            if constexpr (P::GATHER) { if (last) { v200 = vn00; v201 = vn01; v210 = vn10; v211 = vn11; } }
            PG8_LDB(B0, 0, 0); PG8_LDB(B1, 0, 1); PG8_SCHED; PG8_LDA(At, 0, 0); PG8_STAGE_A(PG8_SA(1, 1), Ab, k1, vc10, vc11);
            PG8_WAIT_V(8); PG8_WAIT_L(0); PG8_BAR; PG8_MMA(0, 0, At, B0); PG8_MMA(0, 1, At, B1); PG8_BAR; PG8_SCHED;
            PG8_LDA(At, 0, 1); PG8_STAGE_B(PG8_SB(0, 0), b2); PG8_STAGE_B(PG8_SB(0, 1), b2 + hstepB); PG8_STAGE_A(PG8_SA(0, 0), a2, k2, v200, v201);
            PG8_WAIT_V(8); PG8_WAIT_L(0); PG8_BAR; PG8_MMA(1, 0, At, B0); PG8_MMA(1, 1, At, B1); PG8_BAR; PG8_SCHED;
            PG8_LDB(B0, 1, 0); PG8_LDB(B1, 1, 1); PG8_SCHED; PG8_LDA(At, 1, 0); PG8_STAGE_A(PG8_SA(0, 1), a2, k2, v210, v211);
            PG8_WAIT_V(8); PG8_WAIT_L(0); PG8_BAR; PG8_MMA(0, 0, At, B0); PG8_MMA(0, 1, At, B1); PG8_BAR; PG8_SCHED;
            PG8_LDA(At, 1, 1); PG8_STAGE_B(PG8_SB(1, 0), b3); PG8_STAGE_B(PG8_SB(1, 1), b3 + hstepB); PG8_STAGE_A(PG8_SA(1, 0), a2, k3, v200, v201);
            PG8_WAIT_V(8); PG8_WAIT_L(0); PG8_BAR; PG8_MMA(1, 0, At, B0); PG8_MMA(1, 1, At, B1); PG8_BAR; PG8_SCHED;
        }
        if (PROBE_TIME) { const unsigned long long n_ = wall_clock64(); tk_ += n_ - tm_; tm_ = n_; }
        if constexpr (P::FP8) asm volatile("s_nop 15\n\ts_nop 15\n\ts_nop 15" ::: "memory");
        if (wr == 0) PG8_BAR;
        p.epi(acc, cur, wr, wc, fr, fq);
        if (PROBE_TIME) { asm volatile("s_waitcnt vmcnt(0)" ::: "memory"); const unsigned long long n_ = wall_clock64(); te_ += n_ - tm_; tm_ = n_; }
        if (!has_next) break;
#pragma unroll
        for (int a = 0; a < 2; ++a)
#pragma unroll
            for (int b = 0; b < 2; ++b)
#pragma unroll
                for (int m = 0; m < 4; ++m)
#pragma unroll
                    for (int n = 0; n < 2; ++n) acc[a][b][m][n] = (f32x4){0.f, 0.f, 0.f, 0.f};
        cur = nxt; cB = nB; Ab = nAb; if constexpr (P::GATHER) { vc00 = vn00; vc01 = vn01; vc10 = vn10; vc11 = vn11; } ++ui;
        if (wr == 1) PG8_BAR;
    }
    PG8_WAIT_V(0);
    PG8_BAR;
    if (PROBE_TIME && p.probe && blockIdx.x == 0 && tid_x() == 0) { p.probe[0] = (float)tk_; p.probe[1] = (float)te_; }
#undef PG8_SA
#undef PG8_SB
#undef PG8_STAGE_A
#undef PG8_STAGE_B
#undef PG8_LDA
#undef PG8_LD16
#undef PG8_LDB
#undef PG8_MMA
#undef PG8_WAIT_V
#undef PG8_WAIT_L
#undef PG8_BAR
#undef PG8_SCHED
}
}
using pg8::Unit; using pg8::Acc;

struct DenseBase {
    static constexpr bool FP8 = false;
    float* probe = nullptr;
    const char* Abase; int lda; const bf16_t* Bt; int ldb; int K; int tmid;
    pg8::StaticOrder S;
    __device__ __forceinline__ bool next(int i, Unit& u) const { return S.next(i, u); }
    static constexpr bool GATHER = false;
    __device__ __forceinline__ const char* a_base(const Unit& u) const { return Abase + (size_t)u.pm * 256 * lda * 2; }
    __device__ __forceinline__ unsigned a_row_off(const Unit&, int r) const { return (unsigned)(r * lda) * 2u; }
    __device__ __forceinline__ const char* b_tile(const Unit& u) const { return (const char*)(Bt + (size_t)u.pn * 256 * ldb); }
    __device__ __forceinline__ void mid(Acc&, const Unit&, int, int, int, int) const {}
};

template <bool ROPE> struct ProbBf16 : DenseBase {
    static constexpr bool PERM = true;
    bf16_t* O; int ldc; int rope_pn; const float* cs;
    __device__ __forceinline__ void epi(Acc& acc, const Unit& u, int wr, int wc, int fr, int fq) const {
        asm volatile("" : "+v"(fr), "+v"(fq));
        const int row0 = u.pm * 256 + wr * 64 + fr, colt = u.pn * 256 + wc * 32 + 8 * fq;
        const bool rope = ROPE && (u.pn == rope_pn);
#pragma unroll
        for (int ai = 0; ai < 2; ++ai)
#pragma unroll
            for (int m = 0; m < 4; ++m) { const int row = row0 + ai * 128 + m * 16; bf16_t* rowp = O + (size_t)row * ldc + colt;
#pragma unroll
                for (int bj = 0; bj < 2; ++bj) { f32x4 v0 = acc[ai][bj][m][0], v1 = acc[ai][bj][m][1];
                    if (rope) { const int w = (bj * 128 + wc * 32 + 8 * fq) & 63, i0 = w >> 1;
                        const f32x4 c = *(const f32x4*)(cs + (size_t)row * 64 + i0), s = *(const f32x4*)(cs + (size_t)row * 64 + 32 + i0);
                        f32x4 a, b; a[0] = v0[0] * c[0] - v0[1] * s[0]; a[1] = v0[1] * c[0] + v0[0] * s[0]; a[2] = v0[2] * c[1] - v0[3] * s[1]; a[3] = v0[3] * c[1] + v0[2] * s[1];
                        b[0] = v1[0] * c[2] - v1[1] * s[2]; b[1] = v1[1] * c[2] + v1[0] * s[2]; b[2] = v1[2] * c[3] - v1[3] * s[3]; b[3] = v1[3] * c[3] + v1[2] * s[3]; v0 = a; v1 = b; }
                    u32x4 w4; w4.x = cvt_pk_bf16(v0[0], v0[1]); w4.y = cvt_pk_bf16(v0[2], v0[3]); w4.z = cvt_pk_bf16(v1[0], v1[1]); w4.w = cvt_pk_bf16(v1[2], v1[3]);
                    *(u32x4*)(rowp + bj * 128) = w4; } }
    }
};

struct ProbWout : DenseBase {
    static constexpr bool PERM = false;
    const float* x; float* H1; const float* ssqo; float* ssq1; float sqs;
    __device__ __forceinline__ void mid(Acc& acc, const Unit& u, int wr, int wc, int fr, int fq) const {
        asm volatile("" : "+v"(fr), "+v"(fq));
#pragma unroll
        for (int ai = 0; ai < 2; ++ai)
#pragma unroll
            for (int m = 0; m < 4; ++m) { const int row = u.pm * 256 + ai * 128 + wr * 64 + m * 16 + fr;
                const float sc = __builtin_amdgcn_rsqf(ssqo[row] * (1.0f / 512.0f) + EPS);
#pragma unroll
                for (int bj = 0; bj < 2; ++bj)
#pragma unroll
                    for (int n = 0; n < 2; ++n) acc[ai][bj][m][n] *= sc; }
    }
    __device__ __forceinline__ void epi(Acc& acc, const Unit& u, int wr, int wc, int fr, int fq) const {
        asm volatile("" : "+v"(fr), "+v"(fq));
        const int row0 = u.pm * 256 + wr * 64 + fr, col0 = u.pn * 256 + wc * 32 + 4 * fq;
#pragma unroll
        for (int ai = 0; ai < 2; ++ai)
#pragma unroll
            for (int m = 0; m < 4; ++m) { const int row = row0 + ai * 128 + m * 16; const size_t off = (size_t)row * DM + col0; float q = 0.f;
#pragma unroll
                for (int bj = 0; bj < 2; ++bj)
#pragma unroll
                    for (int n = 0; n < 2; ++n) { const f32x4 v = *(const f32x4*)(x + off + bj * 128 + n * 16) + (DBG_MODE == 2 ? 0.f : 1.f) * acc[ai][bj][m][n];
                        *(f32x4*)(H1 + off + bj * 128 + n * 16) = v; q += (v[0] * v[0] + v[1] * v[1]) + (v[2] * v[2] + v[3] * v[3]); }
                q += __shfl_xor(q, 16); q += __shfl_xor(q, 32);
                if (fq == 0) atomicAdd(ssq1 + row, q * sqs); }
    }
};

struct ProbPle : DenseBase {
    static constexpr bool PERM = false;
    const float* H2; const bf16_t* PP; float* out; float* ssq3; float sqs;
    __device__ __forceinline__ void epi(Acc& acc, const Unit& u, int wr, int wc, int fr, int fq) const {
        asm volatile("" : "+v"(fr), "+v"(fq));
        const int row0 = u.pm * 256 + wr * 64 + fr, col0 = u.pn * 256 + wc * 32 + 4 * fq;
#pragma unroll
        for (int ai = 0; ai < 2; ++ai)
#pragma unroll
            for (int m = 0; m < 4; ++m) { const int row = row0 + ai * 128 + m * 16; const size_t off = (size_t)row * DM + col0; float q = 0.f;
#pragma unroll
                for (int bj = 0; bj < 2; ++bj)
#pragma unroll
                    for (int n = 0; n < 2; ++n) { const f32x4 h = *(const f32x4*)(H2 + off + bj * 128 + n * 16); const u32x2 pw = *(const u32x2*)(PP + off + bj * 128 + n * 16);
                        const f32x4 a = acc[ai][bj][m][n]; f32x4 v;
                        if (DBG_MODE >= 1) { v = h; } else {
                        v[0] = h[0] + sigmoid_f(a[0]) * bflo(pw.x); v[1] = h[1] + sigmoid_f(a[1]) * bfhi(pw.x); v[2] = h[2] + sigmoid_f(a[2]) * bflo(pw.y); v[3] = h[3] + sigmoid_f(a[3]) * bfhi(pw.y); }
                        *(f32x4*)(out + off + bj * 128 + n * 16) = v; q += (v[0] * v[0] + v[1] * v[1]) + (v[2] * v[2] + v[3] * v[3]); }
                q += __shfl_xor(q, 16); q += __shfl_xor(q, 32);
                if (fq == 0) atomicAdd(ssq3 + row, q * sqs); }
    }
};

struct MoeOrder {
    const LAS int* tab; int T, nN, G, c;
    __device__ __forceinline__ bool next(int i, Unit& u) const {
        const int L = i * G + c, x = L & 7, s = L >> 3, q = s / nN; u.pn = s - q * nN; u.pm = x + 8 * q; return u.pm < T;
    }
};
struct ProbMoe1 {
    static constexpr bool PERM = true, FP8 = true, GATHER = true;
    const char* Abase; const unsigned char* Wgu; int ldb; int K; int tmid; MoeOrder S;
    const int* list; const float* bgu; unsigned char* HMID; float* probe = nullptr;
    __device__ __forceinline__ bool next(int i, Unit& u) const { return S.next(i, u); }
    __device__ __forceinline__ const char* a_base(const Unit&) const { return Abase; }
    __device__ __forceinline__ unsigned a_row_off(const Unit& u, int r) const {
        const int t0 = S.tab[2 * u.pm], e = t0 & 255, cnt = t0 >> 8, r0 = S.tab[2 * u.pm + 1];
        const int slot = list[e * NTOK + r0 + (r < cnt ? r : 0)];
        return (unsigned)((slot >> 2) * DM);
    }
    __device__ __forceinline__ const char* b_tile(const Unit& u) const { const int e = S.tab[2 * u.pm] & 255; return (const char*)(Wgu + ((size_t)e * 2048 + (size_t)u.pn * 256) * DM); }
    __device__ __forceinline__ void mid(Acc&, const Unit&, int, int, int, int) const {}
    __device__ __forceinline__ void epi(Acc& acc, const Unit& u, int wr, int wc, int fr, int fq) const {
        asm volatile("" : "+v"(fr), "+v"(fq));
        const int e = S.tab[2 * u.pm] & 255;
        const int j0 = u.pn * 128 + wc * 32 + 8 * fq;
        const float* bg = bgu + (size_t)e * 2048 + j0;
        const f32x4 bg0 = *(const f32x4*)bg, bg1 = *(const f32x4*)(bg + 4), bu0 = *(const f32x4*)(bg + 1024), bu1 = *(const f32x4*)(bg + 1028);
#pragma unroll
        for (int ai = 0; ai < 2; ++ai)
#pragma unroll
            for (int m = 0; m < 4; ++m) { const int row = u.pm * 256 + ai * 128 + wr * 64 + m * 16 + fr; float h[8];
#pragma unroll
                for (int n = 0; n < 2; ++n) { const f32x4 g4 = acc[ai][0][m][n] * (1.0f / 1024.0f) + (n ? bg1 : bg0), u4 = acc[ai][1][m][n] * (1.0f / 1024.0f) + (n ? bu1 : bu0);
#pragma unroll
                    for (int k = 0; k < 4; ++k) { const float g = fminf(g4[k], 7.0f), up = fminf(fmaxf(u4[k], -7.0f), 7.0f); h[n * 4 + k] = (up + 1.0f) * (g * sigmoid_f(1.702f * g)) * 4.0f; } }
                u32x2 w2; w2.x = cvt_pk4_fp8(h[0], h[1], h[2], h[3]); w2.y = cvt_pk4_fp8(h[4], h[5], h[6], h[7]);
                *(u32x2*)(HMID + (size_t)row * DM + j0) = w2; }
    }
};
struct ProbMoe2 {
    static constexpr bool PERM = true, FP8 = true, GATHER = false;
    const char* Abase; const unsigned char* Wdn; int ldb; int K; int tmid; MoeOrder S;
    const int* list; const float* bdn; const float* gatew; bf16_t* YS; float* probe = nullptr;
    __device__ __forceinline__ bool next(int i, Unit& u) const { return S.next(i, u); }
    __device__ __forceinline__ const char* a_base(const Unit& u) const { return Abase + (size_t)u.pm * 256 * DM; }
    __device__ __forceinline__ unsigned a_row_off(const Unit&, int r) const { return (unsigned)(r * DM); }
    __device__ __forceinline__ const char* b_tile(const Unit& u) const { const int e = S.tab[2 * u.pm] & 255; return (const char*)(Wdn + ((size_t)e * 1024 + (size_t)u.pn * 256) * DM); }
    __device__ __forceinline__ void mid(Acc&, const Unit&, int, int, int, int) const {}
    __device__ __forceinline__ void epi(Acc& acc, const Unit& u, int wr, int wc, int fr, int fq) const {
        asm volatile("" : "+v"(fr), "+v"(fq));
        const int t0 = S.tab[2 * u.pm], e = t0 & 255, cnt = t0 >> 8, r0 = S.tab[2 * u.pm + 1];
        const int colt = u.pn * 256 + wc * 32 + 8 * fq;
        f32x4 bv[2][2];
#pragma unroll
        for (int bj = 0; bj < 2; ++bj)
#pragma unroll
            for (int n = 0; n < 2; ++n) bv[bj][n] = *(const f32x4*)(bdn + (size_t)e * DM + colt + bj * 128 + 4 * n);
#pragma unroll
        for (int ai = 0; ai < 2; ++ai)
#pragma unroll
            for (int m = 0; m < 4; ++m) { const int r = ai * 128 + wr * 64 + m * 16 + fr;
                if (r < cnt) { const int slot = list[e * NTOK + r0 + r]; const float gw = gatew[slot]; bf16_t* rowp = YS + (size_t)slot * DM + colt;
#pragma unroll
                    for (int bj = 0; bj < 2; ++bj) { const f32x4 v0 = (acc[ai][bj][m][0] * (1.0f / 256.0f) + bv[bj][0]) * gw, v1 = (acc[ai][bj][m][1] * (1.0f / 256.0f) + bv[bj][1]) * gw;
                        u32x4 w4; w4.x = cvt_pk_bf16(v0[0], v0[1]); w4.y = cvt_pk_bf16(v0[2], v0[3]); w4.z = cvt_pk_bf16(v1[0], v1[1]); w4.w = cvt_pk_bf16(v1[2], v1[3]);
                        *(u32x4*)(rowp + bj * 128) = w4; } } }
    }
};

struct TrTile { f32x4 v[16]; };
template <class KS>
__device__ __forceinline__ void tr_load(TrTile& t, const float* __restrict__ W, int N, int item, int lane, KS ks) {
    const int nblk = (N + 63) >> 6, kb = item / nblk, nb = item - kb * nblk, k0 = 64 * kb, n = 64 * nb + 4 * (lane & 15);
#pragma unroll
    for (int i = 0; i < 16; ++i) { const int k = k0 + 4 * i + (lane >> 4); t.v[i] = (f32x4){0.f, 0.f, 0.f, 0.f}; if (n < N) t.v[i] = *(const f32x4*)(W + (size_t)k * N + n) * ks(k); }
}
template <class Map>
__device__ __forceinline__ void tr_store(const TrTile& t, int N, bf16_t* __restrict__ WT, int ldt, int koff, int kmask, LAS float* scr, int item, int lane, Map map) {
    const int nblk = (N + 63) >> 6, kb = item / nblk, nb = item - kb * nblk, k0 = 64 * kb, n0 = 64 * nb;
#pragma unroll
    for (int i = 0; i < 16; ++i) *(LAS f32x4*)(scr + (4 * i + (lane >> 4)) * 68 + 4 * (lane & 15)) = t.v[i];
    LDS_WAIT(); asm volatile("" ::: "memory");
    const int src = n0 + lane;
    if (src < N) { bf16_t* orow = WT + (size_t)map(src) * ldt;
#pragma unroll
        for (int c = 0; c < 8; ++c) { const LAS float* sp = scr + (8 * c) * 68 + lane;
            u32x4 o; o.x = cvt_pk_bf16(sp[0 * 68], sp[1 * 68]); o.y = cvt_pk_bf16(sp[2 * 68], sp[3 * 68]); o.z = cvt_pk_bf16(sp[4 * 68], sp[5 * 68]); o.w = cvt_pk_bf16(sp[6 * 68], sp[7 * 68]);
            *(u32x4*)(orow + ((k0 + 8 * c + koff) & kmask)) = o; } }
    LDS_WAIT(); asm volatile("" ::: "memory");
}
template <class Map>
__device__ __forceinline__ void tr_store_fp8(const TrTile& t, int N, unsigned char* __restrict__ WT, int ldt, float scale, LAS float* scr, int item, int lane, Map map) {
    const int nblk = (N + 63) >> 6, kb = item / nblk, nb = item - kb * nblk, k0 = 64 * kb, n0 = 64 * nb;
#pragma unroll
    for (int i = 0; i < 16; ++i) *(LAS f32x4*)(scr + (4 * i + (lane >> 4)) * 68 + 4 * (lane & 15)) = t.v[i];
    LDS_WAIT(); asm volatile("" ::: "memory");
    const int src = n0 + lane;
    if (src < N) { unsigned char* orow = WT + (size_t)map(src) * ldt + k0;
#pragma unroll
        for (int c = 0; c < 4; ++c) { const LAS float* sp = scr + (16 * c) * 68 + lane; u32x4 o;
#pragma unroll
            for (int q = 0; q < 4; ++q) o[q] = cvt_pk4_fp8(sp[(4 * q) * 68] * scale, sp[(4 * q + 1) * 68] * scale, sp[(4 * q + 2) * 68] * scale, sp[(4 * q + 3) * 68] * scale);
            *(u32x4*)(orow + 16 * c) = o; } }
    LDS_WAIT(); asm volatile("" ::: "memory");
}
struct KsOne { __device__ __forceinline__ float operator()(int) const { return 1.0f; } };
struct KsWout { const float* g; __device__ __forceinline__ float operator()(int k) const { return k >= 512 ? g[k - 512] : 1.0f; } };
struct MapId { __device__ __forceinline__ int operator()(int n) const { return n; } };
struct MapWin { __device__ __forceinline__ int operator()(int n) const {
    if (n < 2048) return n;
    if (n < 2064) return UC_G + (n - 2048);
    if (n < 2320) return UC_CQ + (n - 2064);
    if (n < 2448) return UC_CKV + (n - 2320);
    const int j = n - 2448; return UC_KR + 2 * (j & 31) + (j >> 5); } };
struct MapWq { __device__ __forceinline__ int operator()(int n) const {
    const int h = n / 192, j = n - h * 192; if (j < 128) return h * 128 + j; const int r = j - 128; return 512 + h * 64 + 2 * (r & 31) + (r >> 5); } };
struct MapWkv { __device__ __forceinline__ int operator()(int n) const {
    const int h = n >> 8, j = n & 255; return j < 128 ? h * 128 + j : 512 + h * 128 + (j - 128); } };
struct MapWgu { __device__ __forceinline__ int operator()(int n) const {
    const int up = n >> 10, j = n & 1023; return 256 * (j >> 7) + 128 * up + (j & 127); } };

__device__ __forceinline__ void p0_prologue(CARGS& a, LAS unsigned char* lds, int vcu, int G) {
    const int tid = tid_x(), lane = tid & 63, wave = __builtin_amdgcn_readfirstlane(tid >> 6);
    unsigned char* ws = a.ws;
    LAS float* scr = (LAS float*)(lds + wave * 17408);
    const int gw = vcu * 8 + wave, NGW = G * 8;
    bf16_t* WIN = (bf16_t*)(ws + WS_WIN); bf16_t* WQ = (bf16_t*)(ws + WS_WQ); bf16_t* WKV = (bf16_t*)(ws + WS_WKV); bf16_t* WOUT = (bf16_t*)(ws + WS_WOUT);
    bf16_t* WPG = (bf16_t*)(ws + WS_WPG); bf16_t* WPP = (bf16_t*)(ws + WS_WPP); unsigned char* WGU = ws + WS_WGU; unsigned char* WDN = ws + WS_WDN;
    constexpr int I_IN = 16 * 40, I_Q = 4 * 12, I_KV = 2 * 16, I_OUT = 16 * 16, I_PG = 16 * 16, I_PP = 4 * 16, I_GU1 = 16 * 32, I_DN1 = 16 * 16;
    constexpr int I_SMALL = I_IN + I_Q + I_KV + I_OUT + I_PG + I_PP, I_GU = NEXP * I_GU1, I_DN = NEXP * I_DN1, NITEMS = I_SMALL + I_GU + I_DN;
#define TR_DISPATCH(OP_GU, OP_DN, OP_IN, OP_Q, OP_KV, OP_OUT, OP_PG, OP_PP, it) do { int r = (it); \
        if (r < I_GU) { const int e = r / I_GU1; r -= e * I_GU1; OP_GU; break; } r -= I_GU; \
        if (r < I_DN) { const int e = r / I_DN1; r -= e * I_DN1; OP_DN; break; } r -= I_DN; \
        if (r < I_IN) { OP_IN; break; } r -= I_IN; if (r < I_Q) { OP_Q; break; } r -= I_Q; if (r < I_KV) { OP_KV; break; } r -= I_KV; \
        if (r < I_OUT) { OP_OUT; break; } r -= I_OUT; if (r < I_PG) { OP_PG; break; } r -= I_PG; OP_PP; } while (0)
#define TR_LOAD(T, it) TR_DISPATCH(tr_load(T, a.in[18] + (size_t)e * 1024 * 2048, 2048, r, lane, KsOne()), tr_load(T, a.in[20] + (size_t)e * 1024 * 1024, 1024, r, lane, KsOne()), \
        tr_load(T, a.in[4], 2512, r, lane, KsOne()), tr_load(T, a.in[10], 768, r, lane, KsOne()), tr_load(T, a.in[12], 1024, r, lane, KsOne()), tr_load(T, a.in[14], 1024, r, lane, KsWout{a.in[13]}), \
        tr_load(T, a.in[23], 1024, r, lane, KsOne()), tr_load(T, a.in[24], 1024, r, lane, KsOne()), it)
#define TR_STORE(T, it) TR_DISPATCH(tr_store_fp8(T, 2048, WGU + (size_t)e * 2048 * 1024, 1024, 64.0f, scr, r, lane, MapWgu()), tr_store_fp8(T, 1024, WDN + (size_t)e * 1024 * 1024, 1024, 64.0f, scr, r, lane, MapId()), \
        tr_store(T, 2512, WIN, 1024, 0, 0x7fffffff, scr, r, lane, MapWin()), tr_store(T, 768, WQ, 256, 0, 0x7fffffff, scr, r, lane, MapWq()), tr_store(T, 1024, WKV, 256, 0, 0x7fffffff, scr, r, lane, MapWkv()), \
        tr_store(T, 1024, WOUT, 1024, 512, 1023, scr, r, lane, MapId()), tr_store(T, 1024, WPG, 1024, 0, 0x7fffffff, scr, r, lane, MapId()), tr_store(T, 1024, WPP, 256, 0, 0x7fffffff, scr, r, lane, MapId()), it)
    { TrTile tA, tB; int it = gw;
      if (it < NITEMS) TR_LOAD(tA, it);
      while (it < NITEMS) {
          const int i1 = it + NGW; if (i1 < NITEMS) TR_LOAD(tB, i1);
          TR_STORE(tA, it);
          if (i1 >= NITEMS) break;
          const int i2 = i1 + NGW; if (i2 < NITEMS) TR_LOAD(tA, i2);
          TR_STORE(tB, i1);
          it = i2; } }
#undef TR_LOAD
#undef TR_STORE
#undef TR_DISPATCH
    const int gt = vcu * 512 + tid, NGT = G * 512;
    for (int i = gt; i < 48 * 1024 / 8; i += NGT) *(u32x4*)(WIN + (size_t)2512 * 1024 + (size_t)i * 8) = (u32x4){0u, 0u, 0u, 0u};
    for (int i = gt; i < 1024 * 16; i += NGT) *(u32x4*)(WKV + (size_t)(i >> 4) * 256 + 128 + (i & 15) * 8) = (u32x4){0u, 0u, 0u, 0u};
    { const float* p = a.in[1]; bf16_t* PB = (bf16_t*)(ws + WS_PB);
      for (int i0 = gt; i0 < NTOK * 256 / 8; i0 += 4 * NGT) { f32x4 x0[4], x1[4];
#pragma unroll
          for (int q = 0; q < 4; ++q) { const size_t i = (size_t)i0 + (size_t)q * NGT; x0[q] = *(const f32x4*)(p + i * 8); x1[q] = *(const f32x4*)(p + i * 8 + 4); }
#pragma unroll
          for (int q = 0; q < 4; ++q) { const size_t i = (size_t)i0 + (size_t)q * NGT;
              u32x4 o; o.x = cvt_pk_bf16(x0[q][0], x0[q][1]); o.y = cvt_pk_bf16(x0[q][2], x0[q][3]); o.z = cvt_pk_bf16(x1[q][0], x1[q][1]); o.w = cvt_pk_bf16(x1[q][2], x1[q][3]); *(u32x4*)(PB + i * 8) = o; } } }
    { const float* x = a.in[0]; const float* g = a.in[3]; bf16_t* XN = (bf16_t*)(ws + WS_XN);
      f32x4 gv[4];
#pragma unroll
      for (int j = 0; j < 4; ++j) gv[j] = *(const f32x4*)(g + 4 * lane + 256 * j);
      for (int m0 = gw * 4; m0 < NTOK; m0 += NGW * 4) { f32x4 v[4][4];
#pragma unroll
          for (int r = 0; r < 4; ++r) { const f32x4* xr = (const f32x4*)(x + (size_t)(m0 + r) * DM) + lane;
#pragma unroll
              for (int j = 0; j < 4; ++j) v[r][j] = xr[64 * j]; }
#pragma unroll
          for (int r = 0; r < 4; ++r) { float s = 0.f;
#pragma unroll
              for (int j = 0; j < 4; ++j) s += (v[r][j][0] * v[r][j][0] + v[r][j][1] * v[r][j][1]) + (v[r][j][2] * v[r][j][2] + v[r][j][3] * v[r][j][3]);
              const float rstd = __builtin_amdgcn_rsqf(wave_sum(s) * (1.0f / DM) + EPS);
              u32x2* o8 = (u32x2*)(XN + (size_t)(m0 + r) * DM) + lane;
#pragma unroll
              for (int j = 0; j < 4; ++j) { u32x2 o; o.x = cvt_pk_bf16(v[r][j][0] * rstd * gv[j][0], v[r][j][1] * rstd * gv[j][1]); o.y = cvt_pk_bf16(v[r][j][2] * rstd * gv[j][2], v[r][j][3] * rstd * gv[j][3]); o8[64 * j] = o; } } } }
}

__device__ __forceinline__ void p2_tail(CARGS& a, int vcu, int G) {
    const int tid = tid_x(), lane = tid & 63, wave = __builtin_amdgcn_readfirstlane(tid >> 6);
    unsigned char* ws = a.ws; const int gw = vcu * 8 + wave, NGW = G * 8;
    bf16_t* U = (bf16_t*)(ws + WS_U); float* CS = (float*)(ws + WS_CS); float* GG = (float*)(ws + WS_G); bf16_t* KPE = (bf16_t*)(ws + WS_KPE);
    const int* positions = (const int*)a.in[2];
    const f32x4 qg = *(const f32x4*)(a.in[9] + 4 * lane); const f32x2 kg = *(const f32x2*)(a.in[11] + 2 * lane);
    const float bgate = lane < 16 ? a.in[5][lane] : 0.f;
    const float freq = __builtin_amdgcn_exp2f(-(float)(lane >> 1) * (13.287712379549449f / 32.0f)) * 0.15915494309189535f;
    for (int m0 = gw * 4; m0 < NTOK; m0 += NGW * 4) {
        u32x2 cqw[4]; unsigned ckw[4]; float krv[4], gvv[4], posf[4];
#pragma unroll
        for (int r = 0; r < 4; ++r) { const bf16_t* ur = U + (size_t)(m0 + r) * NU;
            cqw[r] = *(const u32x2*)(ur + UC_CQ + 4 * lane); ckw[r] = *(const unsigned*)(ur + UC_CKV + 2 * lane);
            krv[r] = bf2f(ur[UC_KR + lane]); gvv[r] = lane < 16 ? bf2f(ur[UC_G + lane]) : 0.f; posf[r] = (float)positions[m0 + r]; }
#pragma unroll
        for (int r = 0; r < 4; ++r) { const int m = m0 + r; bf16_t* ur = U + (size_t)m * NU;
            const float q0 = bflo(cqw[r].x), q1 = bfhi(cqw[r].x), q2 = bflo(cqw[r].y), q3 = bfhi(cqw[r].y), k0 = bflo(ckw[r]), k1 = bfhi(ckw[r]);
            const float rq = __builtin_amdgcn_rsqf(wave_sum((q0 * q0 + q1 * q1) + (q2 * q2 + q3 * q3)) * (1.0f / 256.0f) + EPS);
            const float rk = __builtin_amdgcn_rsqf(wave_sum(k0 * k0 + k1 * k1) * (1.0f / 128.0f) + EPS);
            u32x2 qo; qo.x = cvt_pk_bf16(q0 * rq * qg[0], q1 * rq * qg[1]); qo.y = cvt_pk_bf16(q2 * rq * qg[2], q3 * rq * qg[3]);
            *(u32x2*)(ur + UC_CQ + 4 * lane) = qo; *(unsigned*)(ur + UC_CKV + 2 * lane) = cvt_pk_bf16(k0 * rk * kg[0], k1 * rk * kg[1]);
            float rev = posf[r] * freq; rev -= __builtin_rintf(rev);
            const float cs = __builtin_amdgcn_cosf(rev), sn = __builtin_amdgcn_sinf(rev);
            const float other = __shfl_xor(krv[r], 1);
            const float ro = (lane & 1) ? (krv[r] * cs + other * sn) : (krv[r] * cs - other * sn);
            const unsigned rw = cvt_pk_bf16(ro, __shfl_xor(ro, 1));
            if (!(lane & 1)) { *(unsigned*)(KPE + (size_t)m * 64 + lane) = rw; CS[(size_t)m * 64 + (lane >> 1)] = cs; CS[(size_t)m * 64 + 32 + (lane >> 1)] = sn; }
            if (lane < 16) { float g = gvv[r] + bgate; if ((lane >> 2) & 1) g = fminf(g, 0.f) - __logf(1.0f + __expf(-fabsf(g))); GG[(size_t)m * 16 + lane] = g; } }
    }
}

constexpr int LDP = 136;
constexpr int IMG = 128 * LDP * 2;
__device__ __forceinline__ unsigned lds_addr(const LAS void* p) { return (unsigned)(unsigned long)p; }
__device__ __forceinline__ bf16x8 frag_row(const LAS bf16_t* img, int row, int col) { return *(const LAS bf16x8*)(img + row * LDP + col); }
__device__ __forceinline__ void frag_tr_issue(const LAS bf16_t* img, int k0, int x0, int lane, s16x4& lo, s16x4& hi) {
    const int g = lane >> 4, i = lane & 15, q = i >> 2, p = i & 3;
    const unsigned ad = lds_addr(img + (k0 + 8 * g + q) * LDP + x0 + 4 * p);
    asm volatile("ds_read_b64_tr_b16 %0, %1" : "=v"(lo) : "v"(ad) : "memory");
    asm volatile("ds_read_b64_tr_b16 %0, %1 offset:%2" : "=v"(hi) : "v"(ad), "i"(4 * LDP * 2) : "memory");
}
#define PK8(L, H) (bf16x8){L[0], L[1], L[2], L[3], H[0], H[1], H[2], H[3]}

__device__ __forceinline__ float shfl_up_l(float v, int off, int lane) { const int src = lane >= off ? lane - off : lane; return __int_as_float(__builtin_amdgcn_ds_bpermute(src << 2, __float_as_int(v))); }
__device__ __forceinline__ float shfl_xor_l(float v, int m, int lane) { return __int_as_float(__builtin_amdgcn_ds_bpermute((lane ^ m) << 2, __float_as_int(v))); }
template <bool MAX> __device__ __forceinline__ void scan128(float a0, float a1, int lane, float& o0, float& o1) {
    float inc = MAX ? fmaxf(a0, a1) : a0 + a1;
#pragma unroll
    for (int off = 1; off < 64; off <<= 1) { const float y = shfl_up_l(inc, off, lane); if (lane >= off) inc = MAX ? fmaxf(inc, y) : inc + y; }
    float ex = shfl_up_l(inc, 1, lane); if (lane == 0) ex = MAX ? -INFINITY : 0.f;
    o0 = MAX ? fmaxf(ex, a0) : ex + a0; o1 = MAX ? fmaxf(o0, a1) : o0 + a1;
}
struct GateLds { LAS float* gi; LAS float* bc; LAS float* gg; LAS float* cm; LAS float* ee; LAS float* sc; };
__device__ __forceinline__ GateLds gate_lds(LAS unsigned char* base) {
    GateLds g; g.gi = (LAS float*)base; g.bc = g.gi + 512; g.gg = g.bc + 256; g.cm = g.gg + 256; g.ee = g.cm + 256; g.sc = g.ee + 256; return g;
}
__device__ __forceinline__ void gate_scans(const GateLds& L, int wave, int lane) {
    asm volatile("" : "+v"(lane));
    if (wave < 2) {
        const int d = wave, t0 = d ? 127 - 2 * lane : 2 * lane, t1 = d ? 126 - 2 * lane : 2 * lane + 1;
        const float i0 = L.gi[256 * d + t0], i1 = L.gi[256 * d + t1], f0 = L.gi[256 * d + 128 + t0], f1 = L.gi[256 * d + 128 + t1];
        float b0, b1; scan128<false>(f0, f1, lane, b0, b1);
        const float g0 = i0 - b0, g1 = i1 - b1; float c0, c1; scan128<true>(g0, g1, lane, c0, c1);
        const float gmax = __int_as_float(__builtin_amdgcn_readlane(__float_as_int(c1), 63)), btot = __int_as_float(__builtin_amdgcn_readlane(__float_as_int(b1), 63));
        L.bc[128 * d + t0] = b0; L.bc[128 * d + t1] = b1; L.gg[128 * d + t0] = g0; L.gg[128 * d + t1] = g1; L.cm[128 * d + t0] = c0; L.cm[128 * d + t1] = c1;
        L.ee[128 * d + t0] = fast_exp(g0 - gmax); L.ee[128 * d + t1] = fast_exp(g1 - gmax);
        if (lane == 0) { L.sc[d] = btot; L.sc[2 + d] = gmax; }
    }
}
__device__ __forceinline__ void stage_conv(const bf16_t* __restrict__ U, int tokbase, int spos, int ucol, const float* __restrict__ cw, const float* __restrict__ cb, float scale, LAS bf16_t* dst, int tid) {
    const int cg = tid & 15, c0 = ucol + cg * 8, r0 = tid >> 4;
    float w0[8], w1[8], w2[8], bb[8];
#pragma unroll
    for (int e = 0; e < 8; ++e) { w0[e] = cw[c0 + e]; w1[e] = cw[1024 + c0 + e]; w2[e] = cw[2048 + c0 + e]; bb[e] = cb[c0 + e]; }
#pragma unroll
    for (int j = 0; j < 4; ++j) { const int r = r0 + 32 * j, s = spos + r; const bf16_t* up = U + (size_t)(tokbase + r) * NU + c0;
        const u32x4 z = (u32x4){0u, 0u, 0u, 0u};
        const u32x4 xm = s > 0 ? *(const u32x4*)(up - NU) : z, x0 = *(const u32x4*)up, xp = s < SEQ - 1 ? *(const u32x4*)(up + NU) : z;
        float o[8];
#pragma unroll
        for (int e = 0; e < 4; ++e) { const float a0 = bflo(xm[e]), a1 = bfhi(xm[e]), b0 = bflo(x0[e]), b1 = bfhi(x0[e]), c0_ = bflo(xp[e]), c1_ = bfhi(xp[e]);
            float v0 = w0[2 * e] * a0 + w1[2 * e] * b0 + w2[2 * e] * c0_ + bb[2 * e], v1 = w0[2 * e + 1] * a1 + w1[2 * e + 1] * b1 + w2[2 * e + 1] * c1_ + bb[2 * e + 1];
            o[2 * e] = v0 * sigmoid_f(v0) * scale; o[2 * e + 1] = v1 * sigmoid_f(v1) * scale; }
        u32x4 w; w.x = cvt_pk_bf16(o[0], o[1]); w.y = cvt_pk_bf16(o[2], o[3]); w.z = cvt_pk_bf16(o[4], o[5]); w.w = cvt_pk_bf16(o[6], o[7]);
        *(LAS u32x4*)(dst + r * LDP + cg * 8) = w; }
}

__device__ __forceinline__ void mlstm_local(CARGS& a, LAS unsigned char* lds, int unit) {
    int tid = tid_x(); asm volatile("" : "+v"(tid)); const int lane = tid & 63, wave = __builtin_amdgcn_readfirstlane(tid >> 6);
    unsigned char* ws = a.ws;
    const bf16_t* U = (const bf16_t*)(ws + WS_U); const float* GG = (const float*)(ws + WS_G);
    bf16_t* LOCC = (bf16_t*)(ws + WS_LOCC); float* LOCN = (float*)(ws + WS_LOCN); float* MSC = (float*)(ws + WS_MSC);
    const int c = unit & 31, bh = unit >> 5, h = bh & 3, b = bh >> 2, tokbase = b * SEQ + c * 128;
    LAS bf16_t* Ks = (LAS bf16_t*)lds; LAS bf16_t* Vf = (LAS bf16_t*)(lds + IMG); LAS bf16_t* Vb = (LAS bf16_t*)(lds + 2 * IMG);
    const GateLds L = gate_lds(lds + 4 * IMG);
    { const int t = tid & 127, k = tid >> 7; L.gi[k * 128 + t] = GG[(size_t)(tokbase + t) * 16 + k * 4 + h]; }
    stage_conv(U, tokbase, c * 128, UC_K + h * 128, a.in[6], a.in[7], 0.08838834764831845f, Ks, tid);
    const int cg = tid & 15, r0 = tid >> 4; u32x4 vr[4];
#pragma unroll
    for (int j = 0; j < 4; ++j) vr[j] = *(const u32x4*)(U + (size_t)(tokbase + r0 + 32 * j) * NU + UC_V + h * 128 + cg * 8);
    __syncthreads();
    gate_scans(L, wave, lane);
    __syncthreads();
#pragma unroll
    for (int j = 0; j < 4; ++j) { const int r = r0 + 32 * j; const float ef = L.ee[r], eb = L.ee[128 + r]; u32x4 wf, wb;
#pragma unroll
        for (int e = 0; e < 4; ++e) { const float lo = bflo(vr[j][e]), hi = bfhi(vr[j][e]); wf[e] = cvt_pk_bf16(lo * ef, hi * ef); wb[e] = cvt_pk_bf16(lo * eb, hi * eb); }
        *(LAS u32x4*)(Vf + r * LDP + cg * 8) = wf; *(LAS u32x4*)(Vb + r * LDP + cg * 8) = wb; }
    __syncthreads();
    if (tid < 256) { const int d = tid >> 7, dk = tid & 127; float s = 0.f;
#pragma unroll 8
        for (int t = 0; t < 128; ++t) s += L.ee[128 * d + t] * bf2f(Ks[t * LDP + dk]);
        LOCN[(size_t)(unit * 2 + d) * 128 + dk] = s; }
    if (tid < 2) { MSC[(unit * 2 + tid) * 4 + 0] = L.sc[tid]; MSC[(unit * 2 + tid) * 4 + 1] = L.sc[tid] + L.sc[2 + tid]; }
    const int d = wave >> 2, dvb = 32 * (wave & 3); const LAS bf16_t* Vw = d ? Vb : Vf;
    f32x4 acc[2][8];
#pragma unroll
    for (int i = 0; i < 2; ++i)
#pragma unroll
        for (int j = 0; j < 8; ++j) acc[i][j] = (f32x4){0.f, 0.f, 0.f, 0.f};
#pragma unroll
    for (int ks = 0; ks < 4; ++ks) { s16x4 vl[2], vh[2], kl[8], kh[8];
#pragma unroll
        for (int i = 0; i < 2; ++i) frag_tr_issue(Vw, 32 * ks, dvb + 16 * i, lane, vl[i], vh[i]);
#pragma unroll
        for (int j = 0; j < 8; ++j) frag_tr_issue(Ks, 32 * ks, 16 * j, lane, kl[j], kh[j]);
        LDS_WAIT(); SBAR();
#pragma unroll
        for (int i = 0; i < 2; ++i)
#pragma unroll
            for (int j = 0; j < 8; ++j) acc[i][j] = __builtin_amdgcn_mfma_f32_16x16x32_bf16(PK8(kl[j], kh[j]), PK8(vl[i], vh[i]), acc[i][j], 0, 0, 0); }
    bf16_t* outp = LOCC + (size_t)(unit * 2 + d) * 16384;
#pragma unroll
    for (int i = 0; i < 2; ++i)
#pragma unroll
        for (int j = 0; j < 8; ++j) { u32x2 w; w.x = cvt_pk_bf16(acc[i][j][0], acc[i][j][1]); w.y = cvt_pk_bf16(acc[i][j][2], acc[i][j][3]);
            *(u32x2*)(outp + (dvb + 16 * i + (lane & 15)) * 128 + 16 * j + 4 * (lane >> 4)) = w; }
    __syncthreads();
}

__device__ __forceinline__ void mlstm_scan(CARGS& a, int vcu, int G) {
    unsigned char* ws = a.ws; bf16_t* LOCC = (bf16_t*)(ws + WS_LOCC); float* LOCN = (float*)(ws + WS_LOCN); float* MSC = (float*)(ws + WS_MSC);
    const int gt = vcu * 512 + tid_x(), NGT = G * 512;
    for (int idx = gt; idx < 64 * 2048; idx += NGT) {
        const int seq = idx >> 11, e8 = idx & 2047, bh = seq >> 1, d = seq & 1;
        float st[8], sn[8]; float m = 0.f;
#pragma unroll
        for (int k = 0; k < 8; ++k) { st[k] = 0.f; sn[k] = 0.f; }
        const bool don = e8 < 16;
#pragma unroll 1
        for (int cb = 0; cb < 32; cb += 8) {
            u32x4 ld[8]; f32x4 n0[8], n1[8];
#pragma unroll
            for (int k = 0; k < 8; ++k) { const int c = d ? 31 - (cb + k) : cb + k; const int un = (bh * 32 + c) * 2 + d;
                ld[k] = *(const u32x4*)(LOCC + (size_t)un * 16384 + e8 * 8);
                if (DBG_MODE == 7) { const unsigned pat = 0x3c003c00u + (unsigned)((e8 * 7 + c) & 63); ld[k] = (u32x4){pat, pat, pat, pat}; }
                if (don) { n0[k] = *(const f32x4*)(LOCN + (size_t)un * 128 + e8 * 8); n1[k] = *(const f32x4*)(LOCN + (size_t)un * 128 + e8 * 8 + 4); } }
#pragma unroll
            for (int k = 0; k < 8; ++k) { const int c = d ? 31 - (cb + k) : cb + k; const int un = (bh * 32 + c) * 2 + d;
                const float bt = MSC[un * 4 + 0], mw = MSC[un * 4 + 1];
                const float mn = fmaxf(bt + m, mw), fa = fast_exp(bt + m - mn), fc = fast_exp(mw - mn);
                u32x4 pv; pv.x = cvt_pk_bf16(st[0], st[1]); pv.y = cvt_pk_bf16(st[2], st[3]); pv.z = cvt_pk_bf16(st[4], st[5]); pv.w = cvt_pk_bf16(st[6], st[7]);
                *(u32x4*)(LOCC + (size_t)un * 16384 + e8 * 8) = pv;
#pragma unroll
                for (int q = 0; q < 4; ++q) { st[2 * q] = fa * st[2 * q] + fc * bflo(ld[k][q]); st[2 * q + 1] = fa * st[2 * q + 1] + fc * bfhi(ld[k][q]); }
                if (don) { *(f32x4*)(LOCN + (size_t)un * 128 + e8 * 8) = (f32x4){sn[0], sn[1], sn[2], sn[3]}; *(f32x4*)(LOCN + (size_t)un * 128 + e8 * 8 + 4) = (f32x4){sn[4], sn[5], sn[6], sn[7]};
#pragma unroll
                    for (int q = 0; q < 4; ++q) { sn[q] = fa * sn[q] + fc * n0[k][q]; sn[4 + q] = fa * sn[4 + q] + fc * n1[k][q]; } }
                if (e8 == 0) MSC[un * 4 + 2] = m;
                m = mn; }
        }
    }
}

__device__ __forceinline__ void mlstm_out(CARGS& a, LAS unsigned char* lds, int unit) {
    int tid = tid_x(); asm volatile("" : "+v"(tid)); const int lane = tid & 63, wave = __builtin_amdgcn_readfirstlane(tid >> 6);
    unsigned char* ws = a.ws;
    const bf16_t* U = (const bf16_t*)(ws + WS_U); const float* GG = (const float*)(ws + WS_G);
    const bf16_t* CPREV = (const bf16_t*)(ws + WS_LOCC); const float* NPREV = (const float*)(ws + WS_LOCN); const float* MSC = (const float*)(ws + WS_MSC);
    bf16_t* Y = (bf16_t*)(ws + WS_Y);
    const int c = unit & 31, bh = unit >> 5, h = bh & 3, b = bh >> 2, tokbase = b * SEQ + c * 128;
    LAS bf16_t* Qs = (LAS bf16_t*)lds; LAS bf16_t* Ks = (LAS bf16_t*)(lds + IMG); LAS bf16_t* CF = (LAS bf16_t*)(lds + 2 * IMG); LAS bf16_t* CB = (LAS bf16_t*)(lds + 3 * IMG);
    const GateLds L = gate_lds(lds + 4 * IMG);
    LAS float* np = (LAS float*)(lds + 4 * IMG + 6400); LAS float* mp = np + 256;
    { const int t = tid & 127, k = tid >> 7; L.gi[k * 128 + t] = GG[(size_t)(tokbase + t) * 16 + k * 4 + h]; }
    if (tid < 256) np[tid] = NPREV[(size_t)(unit * 2 + (tid >> 7)) * 128 + (tid & 127)];
    if (tid < 2) mp[tid] = MSC[(unit * 2 + tid) * 4 + 2];
    stage_conv(U, tokbase, c * 128, UC_Q + h * 128, a.in[6], a.in[7], 1.0f, Qs, tid);
    stage_conv(U, tokbase, c * 128, UC_K + h * 128, a.in[6], a.in[7], 0.08838834764831845f, Ks, tid);
#pragma unroll
    for (int d = 0; d < 2; ++d) { const bf16_t* src = CPREV + (size_t)(unit * 2 + d) * 16384; LAS bf16_t* dst = d ? CB : CF;
#pragma unroll
        for (int j = 0; j < 4; ++j) { const int v = tid + 512 * j; *(LAS u32x4*)(dst + (v >> 4) * LDP + (v & 15) * 8) = *(const u32x4*)(src + (size_t)v * 8); } }
    __syncthreads();
    gate_scans(L, wave, lane);
    __syncthreads();
    int lane_b = lane; asm volatile("" : "+v"(lane_b));
    const int t0 = 16 * wave, tl = lane_b & 15, fq = lane_b >> 4, t = t0 + tl;
    bf16x8 qf[4];
#pragma unroll
    for (int ks = 0; ks < 4; ++ks) qf[ks] = frag_row(Qs, t, 32 * ks + 8 * fq);
    f32x4 sacc[8], accf[8], accb[8];
#pragma unroll
    for (int j = 0; j < 8; ++j) { sacc[j] = (f32x4){0.f, 0.f, 0.f, 0.f}; accf[j] = sacc[j]; accb[j] = sacc[j]; }
#pragma unroll
    for (int ks = 0; ks < 4; ++ks) {
#pragma unroll
        for (int j = 0; j < 8; ++j) sacc[j] = __builtin_amdgcn_mfma_f32_16x16x32_bf16(frag_row(Ks, 16 * j + tl, 32 * ks + 8 * fq), qf[ks], sacc[j], 0, 0, 0);
        SBAR(); }
#pragma unroll
    for (int ks = 0; ks < 4; ++ks) {
#pragma unroll
        for (int j = 0; j < 8; ++j) accf[j] = __builtin_amdgcn_mfma_f32_16x16x32_bf16(frag_row(CF, 16 * j + tl, 32 * ks + 8 * fq), qf[ks], accf[j], 0, 0, 0);
        SBAR(); }
#pragma unroll
    for (int ks = 0; ks < 4; ++ks) {
#pragma unroll
        for (int j = 0; j < 8; ++j) accb[j] = __builtin_amdgcn_mfma_f32_16x16x32_bf16(frag_row(CB, 16 * j + tl, 32 * ks + 8 * fq), qf[ks], accb[j], 0, 0, 0);
        SBAR(); }
    float qnf = 0.f, qnb = 0.f;
#pragma unroll
    for (int k = 0; k < 4; ++k) { const bf16x8 qv = frag_row(Qs, t, 32 * fq + 8 * k);
#pragma unroll
        for (int e = 0; e < 8; ++e) { const float q = bf2f((bf16_t)qv[e]); qnf += q * np[32 * fq + 8 * k + e]; qnb += q * np[128 + 32 * fq + 8 * k + e]; } }
    qnf += shfl_xor_l(qnf, 16, lane); qnf += shfl_xor_l(qnf, 32, lane); qnb += shfl_xor_l(qnb, 16, lane); qnb += shfl_xor_l(qnb, 32, lane);
    const int cg = tid & 15, r0 = tid >> 4; u32x4 vr[4];
#pragma unroll
    for (int j = 0; j < 4; ++j) vr[j] = *(const u32x4*)(U + (size_t)(tokbase + r0 + 32 * j) * NU + UC_V + h * 128 + cg * 8);
    __syncthreads();
#pragma unroll
    for (int j = 0; j < 4; ++j) *(LAS u32x4*)(CF + (r0 + 32 * j) * LDP + cg * 8) = vr[j];
    const float Mf = fmaxf(mp[0], L.cm[t]), Mb = fmaxf(mp[1], L.cm[128 + t]);
    float rsf = 0.f, rsb = 0.f;
#pragma unroll
    for (int j = 0; j < 8; ++j) { const int s0 = 16 * j + 4 * fq; const f32x4 gf = *(const LAS f32x4*)(L.gg + s0), gb = *(const LAS f32x4*)(L.gg + 128 + s0);
        float pf[4], pb[4];
#pragma unroll
        for (int r = 0; r < 4; ++r) { const int s = s0 + r; const float wf = (s <= t) ? fast_exp(gf[r] - Mf) : 0.f, wb = (s >= t) ? fast_exp(gb[r] - Mb) : 0.f;
            pf[r] = sacc[j][r] * wf; pb[r] = sacc[j][r] * wb; rsf += pf[r]; rsb += pb[r]; }
        u32x2 wf2, wb2; wf2.x = cvt_pk_bf16(pf[0], pf[1]); wf2.y = cvt_pk_bf16(pf[2], pf[3]); wb2.x = cvt_pk_bf16(pb[0], pb[1]); wb2.y = cvt_pk_bf16(pb[2], pb[3]);
        *(LAS u32x2*)(Qs + t * LDP + s0) = wf2; *(LAS u32x2*)(Ks + t * LDP + s0) = wb2; }
    rsf += shfl_xor_l(rsf, 16, lane); rsf += shfl_xor_l(rsf, 32, lane); rsb += shfl_xor_l(rsb, 16, lane); rsb += shfl_xor_l(rsb, 32, lane);
    float af = fast_exp(mp[0] - Mf), ab = fast_exp(mp[1] - Mb);
    if (DBG_MODE == 5) { af = 0.f; ab = 0.f; }
#pragma unroll
    for (int j = 0; j < 8; ++j) { accf[j] *= (DBG_MODE == 6 ? 0.f : af); accb[j] *= (DBG_MODE == 6 ? 0.f : ab); }
    __syncthreads();
#pragma unroll
    for (int ks = 0; ks < 4; ++ks) { const bf16x8 pff = frag_row(Qs, t, 32 * ks + 8 * fq), pbf = frag_row(Ks, t, 32 * ks + 8 * fq);
        s16x4 vl[8], vh[8];
#pragma unroll
        for (int j = 0; j < 8; ++j) frag_tr_issue(CF, 32 * ks, 16 * j, lane, vl[j], vh[j]);
        LDS_WAIT(); SBAR();
#pragma unroll
        for (int j = 0; j < 8; ++j) { const bf16x8 vf = PK8(vl[j], vh[j]);
            accf[j] = __builtin_amdgcn_mfma_f32_16x16x32_bf16(vf, pff, accf[j], 0, 0, 0);
            accb[j] = __builtin_amdgcn_mfma_f32_16x16x32_bf16(vf, pbf, accb[j], 0, 0, 0); } }
    const float denf = rsf + af * qnf, denb = rsb + ab * qnb;
    const float invf = 1.0f / fmaxf(fabsf(denf), fast_exp(-(L.bc[t] + Mf))), invb = 1.0f / fmaxf(fabsf(denb), fast_exp(-(L.bc[128 + t] + Mb)));
    float ssq = 0.f;
#pragma unroll
    for (int j = 0; j < 8; ++j) { accf[j] = accf[j] * invf + accb[j] * invb; ssq += (accf[j][0] * accf[j][0] + accf[j][1] * accf[j][1]) + (accf[j][2] * accf[j][2] + accf[j][3] * accf[j][3]); }
    int l2 = lane_id(); asm volatile("" : "+v"(l2));
    ssq += shfl_xor_l(ssq, 16, l2); ssq += shfl_xor_l(ssq, 32, l2);
    const float rstd = __builtin_amdgcn_rsqf(ssq * (1.0f / 128.0f) + EPS);
    const int fq2 = l2 >> 4; const float* gn = a.in[8] + h * 128; const size_t tok = (size_t)(tokbase + 16 * wave + (l2 & 15));
#pragma unroll
    for (int j = 0; j < 8; ++j) { const int dv = 16 * j + 4 * fq2; const f32x4 g4 = *(const f32x4*)(gn + dv); const u32x2 ow = *(const u32x2*)(U + tok * NU + UC_O + h * 128 + dv);
        const float y0 = accf[j][0] * rstd * g4[0] * sigmoid_f(bflo(ow.x)), y1 = accf[j][1] * rstd * g4[1] * sigmoid_f(bfhi(ow.x));
        const float y2 = accf[j][2] * rstd * g4[2] * sigmoid_f(bflo(ow.y)), y3 = accf[j][3] * rstd * g4[3] * sigmoid_f(bfhi(ow.y));
        u32x2 w; w.x = cvt_pk_bf16(y0, y1); w.y = cvt_pk_bf16(y2, y3); if (DBG_MODE == 4) { w.x = 0u; w.y = 0u; }
        *(u32x2*)(Y + tok * DM + 512 + h * 128 + dv) = w; }
    __syncthreads();
}

namespace att {
constexpr int QBLK = 32, KVBLK = 64;
constexpr float SCALE = 0.07216878364870322f;
constexpr float THR = 8.f;
constexpr int LDQ = 768, LDK = 1024, LDR = 64;
constexpr int SHM_V = 16384, SHM_K = 16384, SHM_R = 8192;
constexpr int OFF_V = 0, OFF_K = 2 * SHM_V, OFF_R = OFF_K + 2 * SHM_K, OFF_WS = OFF_R + 2 * SHM_R, OFF_QR = OFF_WS + 2048;
#define KSWZ(row, colB) ((row) * 256 + ((colB) ^ (((row) & 7) << 4)))
#define RSWZ(row, colB) ((row) * 128 + ((colB) ^ (((row) & 7) << 4)))
__device__ __forceinline__ int crow(int r, int hi) { return (r & 3) + 8 * (r >> 2) + 4 * hi; }
__device__ __forceinline__ void partialSM(f32x16& p0, f32x16& p1, float& m_reg, float& mn, float& alpha) {
  constexpr float C = SCALE * 1.4426950408889634f;
  float pmax = p0[0];
#pragma unroll
  for (int r = 1; r < 16; ++r) pmax = fmaxf(pmax, p0[r]);
#pragma unroll
  for (int r = 0; r < 16; ++r) pmax = fmaxf(pmax, p1[r]);
  { auto rr = __builtin_amdgcn_permlane32_swap(__float_as_uint(pmax), __float_as_uint(pmax), false, false);
    pmax = fmaxf(__uint_as_float(rr[0]), __uint_as_float(rr[1])); }
  if (__builtin_expect(__all(pmax - m_reg <= THR / SCALE), 1)) { mn = m_reg; alpha = 1.f; }
  else { mn = fmaxf(m_reg, pmax); alpha = __builtin_amdgcn_exp2f((m_reg - mn) * C); m_reg = mn; }
  const float mnC = -mn * C;
#pragma unroll
  for (int r = 0; r < 16; ++r) p0[r] = fmaf(p0[r], C, mnC);
#pragma unroll
  for (int r = 0; r < 16; ++r) p1[r] = fmaf(p1[r], C, mnC);
#pragma unroll
  for (int r = 0; r < 16; ++r) p0[r] = __builtin_amdgcn_exp2f(p0[r]);
}
__device__ __forceinline__ void finishSM(f32x16& p0, f32x16& p1, float alpha, float& l_reg, bf16x8& pa0, bf16x8& pa1, bf16x8& pa2, bf16x8& pa3) {
#pragma unroll
  for (int r = 0; r < 16; ++r) p1[r] = __builtin_amdgcn_exp2f(p1[r]);
  float ps = 0;
#pragma unroll
  for (int r = 0; r < 16; ++r) ps += p0[r];
#pragma unroll
  for (int r = 0; r < 16; ++r) ps += p1[r];
  { auto rr = __builtin_amdgcn_permlane32_swap(__float_as_uint(ps), __float_as_uint(ps), false, false);
    ps = __uint_as_float(rr[0]) + __uint_as_float(rr[1]); }
  l_reg = l_reg * alpha + ps;
#define PK4(P, BASE, OUT) do { unsigned a0 = cvt_pk_bf16(P[BASE + 0], P[BASE + 1]), a1 = cvt_pk_bf16(P[BASE + 2], P[BASE + 3]);   \
    unsigned b0 = cvt_pk_bf16(P[BASE + 4], P[BASE + 5]), b1 = cvt_pk_bf16(P[BASE + 6], P[BASE + 7]);                              \
    auto r0 = __builtin_amdgcn_permlane32_swap(a0, b0, false, false); auto r1 = __builtin_amdgcn_permlane32_swap(a1, b1, false, false); \
    u32x4 w = {r0[0], r1[0], r0[1], r1[1]}; OUT = *reinterpret_cast<bf16x8*>(&w); } while (0)
  PK4(p0, 0, pa0); PK4(p0, 8, pa1); PK4(p1, 0, pa2); PK4(p1, 8, pa3);
#undef PK4
}
__device__ __forceinline__ void qkt(f32x16& p0, f32x16& p1, const LAS char* Ks, const LAS char* Rs, const bf16x8* qr, const LAS char* Qrs, int r32, int hi) {
  p0 = f32x16{}; p1 = f32x16{};
#pragma unroll
  for (int d0 = 0; d0 < 8; ++d0) { const int cb = (d0 * 16 + hi * 8) * 2;
    const bf16x8 b0 = *reinterpret_cast<const LAS bf16x8*>(Ks + KSWZ(r32, cb));
    const bf16x8 b1 = *reinterpret_cast<const LAS bf16x8*>(Ks + KSWZ(32 + r32, cb));
    p0 = __builtin_amdgcn_mfma_f32_32x32x16_bf16(b0, qr[d0], p0, 0, 0, 0);
    p1 = __builtin_amdgcn_mfma_f32_32x32x16_bf16(b1, qr[d0], p1, 0, 0, 0); }
#pragma unroll
  for (int d0 = 0; d0 < 4; ++d0) { const int cb = (d0 * 16 + hi * 8) * 2;
    const bf16x8 b0 = *reinterpret_cast<const LAS bf16x8*>(Rs + RSWZ(r32, cb));
    const bf16x8 b1 = *reinterpret_cast<const LAS bf16x8*>(Rs + RSWZ(32 + r32, cb));
    const bf16x8 qv = *reinterpret_cast<const LAS bf16x8*>(Qrs + RSWZ(r32, cb));
    p0 = __builtin_amdgcn_mfma_f32_32x32x16_bf16(b0, qv, p0, 0, 0, 0);
    p1 = __builtin_amdgcn_mfma_f32_32x32x16_bf16(b1, qv, p1, 0, 0, 0); }
}
__device__ __forceinline__ int v_st(int k, int c) { const int kk = (k & ~0xC) | ((k & 4) << 1) | ((k & 8) >> 1); return ((kk >> 3) * 4 + (c >> 5)) * 512 + ((kk & 7) * 32 + (c & 31)) * 2; }
__device__ __forceinline__ int v_rd_base(int lane) { return ((lane & 3) << 3) | (((lane >> 2) & 3) << 6) | (((lane >> 4) & 1) << 5) | (((lane >> 5) & 1) << 8); }
constexpr int v_rd_off(int d0, int ks, int half) { return d0 * 512 + ks * 4096 + half * 2048; }
template <int OFF> __device__ __forceinline__ s16x4 tr_read(int vb) {
  s16x4 r; asm volatile("ds_read_b64_tr_b16 %0, %1 offset:%2" : "=&v"(r) : "v"(vb), "i"(OFF) : "memory"); return r;
}
template <int D0> __device__ __forceinline__ void pv_one(f32x16& od, int vb, bf16x8 pa0, bf16x8 pa1, bf16x8 pa2, bf16x8 pa3) {
  const s16x4 l0 = tr_read<v_rd_off(D0, 0, 0)>(vb), h0 = tr_read<v_rd_off(D0, 0, 1)>(vb), l1 = tr_read<v_rd_off(D0, 1, 0)>(vb), h1 = tr_read<v_rd_off(D0, 1, 1)>(vb);
  const s16x4 l2 = tr_read<v_rd_off(D0, 2, 0)>(vb), h2 = tr_read<v_rd_off(D0, 2, 1)>(vb), l3 = tr_read<v_rd_off(D0, 3, 0)>(vb), h3 = tr_read<v_rd_off(D0, 3, 1)>(vb);
  asm volatile("s_waitcnt lgkmcnt(0)" ::: "memory"); SBAR();
  od = __builtin_amdgcn_mfma_f32_32x32x16_bf16(pa0, PK8(l0, h0), od, 0, 0, 0);
  od = __builtin_amdgcn_mfma_f32_32x32x16_bf16(pa1, PK8(l1, h1), od, 0, 0, 0);
  od = __builtin_amdgcn_mfma_f32_32x32x16_bf16(pa2, PK8(l2, h2), od, 0, 0, 0);
  od = __builtin_amdgcn_mfma_f32_32x32x16_bf16(pa3, PK8(l3, h3), od, 0, 0, 0);
}
__device__ __forceinline__ void pv_d0(f32x16* o, int vb, bf16x8 pa0, bf16x8 pa1, bf16x8 pa2, bf16x8 pa3) {
  pv_one<0>(o[0], vb, pa0, pa1, pa2, pa3); pv_one<1>(o[1], vb, pa0, pa1, pa2, pa3); pv_one<2>(o[2], vb, pa0, pa1, pa2, pa3); pv_one<3>(o[3], vb, pa0, pa1, pa2, pa3);
}
__device__ __forceinline__ void attn_unit(const bf16_t* __restrict__ Qn, const bf16_t* __restrict__ Qr, const bf16_t* __restrict__ Kh, const bf16_t* __restrict__ Vh, const bf16_t* __restrict__ Rh,
                                          bf16_t* __restrict__ Ob, float* __restrict__ ssq, float sqs, int seq, LAS unsigned char* lds) {
  int tid = tid_x(); asm volatile("" : "+v"(tid)); const int wid = tid >> 6, lane = tid & 63, r32 = lane & 31, hi = lane >> 5;
  LAS char* V_lds = (LAS char*)lds + OFF_V; LAS char* K_lds = (LAS char*)lds + OFF_K; LAS char* R_lds = (LAS char*)lds + OFF_R;
  LAS float* wsl = (LAS float*)(lds + OFF_WS) + wid * 64; LAS float* li_l = wsl; LAS float* al_l = wsl + 32;
  float m_reg = -1e30f, l_reg = 0; f32x16 o[4] = {}; bf16x8 qr[8];
  LAS char* Qrs = (LAS char*)lds + OFF_QR + wid * 4096;
  { const bf16_t* Qw = Qn + (size_t)(wid * QBLK + r32) * LDQ + hi * 8; const bf16_t* Qv = Qr + (size_t)(wid * QBLK + r32) * LDQ + hi * 8;
#pragma unroll
    for (int d0 = 0; d0 < 8; ++d0) qr[d0] = *reinterpret_cast<const bf16x8*>(Qw + d0 * 16);
#pragma unroll
    for (int d0 = 0; d0 < 4; ++d0) *(LAS bf16x8*)(Qrs + RSWZ(r32, (d0 * 16 + hi * 8) * 2)) = *reinterpret_cast<const bf16x8*>(Qv + d0 * 16); }
  const int sr = tid >> 4, sc = (tid & 15) * 8, vst0 = v_st(sr, sc), vst1 = v_st(32 + sr, sc);
  const int rr = tid >> 3, rc = (tid & 7) * 8;
  const int vb0 = (int)lds_addr(V_lds) + v_rd_base(lane);
  bf16x8 vs0, vs1, ks0, ks1, rs0;
#define SLOAD(k0) do { vs0 = *reinterpret_cast<const bf16x8*>(&Vh[(size_t)((k0) + sr) * LDK + sc]); vs1 = *reinterpret_cast<const bf16x8*>(&Vh[(size_t)((k0) + 32 + sr) * LDK + sc]); \
    ks0 = *reinterpret_cast<const bf16x8*>(&Kh[(size_t)((k0) + sr) * LDK + sc]); ks1 = *reinterpret_cast<const bf16x8*>(&Kh[(size_t)((k0) + 32 + sr) * LDK + sc]); \
    rs0 = *reinterpret_cast<const bf16x8*>(&Rh[(size_t)((k0) + rr) * LDR + rc]); } while (0)
#define SWRITE(b) do { *(LAS bf16x8*)(V_lds + (b) * SHM_V + vst0) = vs0; *(LAS bf16x8*)(V_lds + (b) * SHM_V + vst1) = vs1; const int kc = sc * 2;               \
    *(LAS bf16x8*)(K_lds + (b) * SHM_K + KSWZ(sr, kc)) = ks0; *(LAS bf16x8*)(K_lds + (b) * SHM_K + KSWZ(32 + sr, kc)) = ks1;                       \
    *(LAS bf16x8*)(R_lds + (b) * SHM_R + RSWZ(rr, rc * 2)) = rs0; } while (0)
#define RESC(a) do { if (__any((a) < 1.f)) { if (hi == 0) al_l[r32] = (a); asm volatile("s_waitcnt lgkmcnt(0)" ::: "memory"); \
    _Pragma("unroll") for (int d = 0; d < 4; ++d) _Pragma("unroll") for (int r = 0; r < 16; ++r) o[d][r] *= al_l[crow(r, hi)]; } } while (0)
  f32x16 pA0, pA1, pB0, pB1; float mnA, mnB, alA, alB; bf16x8 pa0, pa1, pa2, pa3; const int NT = seq / KVBLK;
  SLOAD(0); asm volatile("s_waitcnt vmcnt(0)" ::: "memory"); SWRITE(0); __syncthreads();
  qkt(pA0, pA1, K_lds, R_lds, qr, Qrs, r32, hi); partialSM(pA0, pA1, m_reg, mnA, alA);
  SLOAD(KVBLK);
  asm volatile("s_waitcnt vmcnt(0)" ::: "memory"); SWRITE(1); __syncthreads();
  for (int j = 1; j + 1 < NT; j += 2) {
    SBAR(); qkt(pB0, pB1, K_lds + SHM_K, R_lds + SHM_R, qr, Qrs, r32, hi);
    finishSM(pA0, pA1, alA, l_reg, pa0, pa1, pa2, pa3); SBAR();
    SLOAD((j + 1) * KVBLK); SBAR();
    pv_d0(o, vb0, pa0, pa1, pa2, pa3); partialSM(pB0, pB1, m_reg, mnB, alB);
    __syncthreads(); asm volatile("s_waitcnt vmcnt(0)" ::: "memory"); SWRITE(0);
    RESC(alB); __syncthreads();
    SBAR(); qkt(pA0, pA1, K_lds, R_lds, qr, Qrs, r32, hi);
    finishSM(pB0, pB1, alB, l_reg, pa0, pa1, pa2, pa3); SBAR();
    SLOAD((j + 2) * KVBLK); SBAR();
    pv_d0(o, vb0 + SHM_V, pa0, pa1, pa2, pa3); partialSM(pA0, pA1, m_reg, mnA, alA);
    __syncthreads(); asm volatile("s_waitcnt vmcnt(0)" ::: "memory"); SWRITE(1);
    RESC(alA); __syncthreads();
  }
  SBAR(); qkt(pB0, pB1, K_lds + SHM_K, R_lds + SHM_R, qr, Qrs, r32, hi);
  finishSM(pA0, pA1, alA, l_reg, pa0, pa1, pa2, pa3); SBAR();
  pv_d0(o, vb0, pa0, pa1, pa2, pa3); partialSM(pB0, pB1, m_reg, mnB, alB);
  __syncthreads(); RESC(alB);
  finishSM(pB0, pB1, alB, l_reg, pa0, pa1, pa2, pa3); SBAR();
  pv_d0(o, vb0 + SHM_V, pa0, pa1, pa2, pa3);
  if (hi == 0) li_l[r32] = l_reg; asm volatile("s_waitcnt lgkmcnt(0)" ::: "memory");
  bf16_t* Ow = Ob + (size_t)(wid * QBLK) * DM; float* sq = ssq + wid * QBLK;
#pragma unroll
  for (int r = 0; r < 16; ++r) { const int orow = crow(r, hi); const float rl = __builtin_amdgcn_rcpf(li_l[orow]); float q = 0.f;
#pragma unroll
    for (int d0 = 0; d0 < 4; ++d0) { const float v = o[d0][r] * rl; q += v * v; Ow[(size_t)orow * DM + d0 * 32 + r32] = (DBG_MODE == 3 || DBG_MODE >= 5) ? (bf16_t)0 : (bf16_t)(cvt_pk_bf16(v, v) & 0xffffu); }
    q += __shfl_xor(q, 1); q += __shfl_xor(q, 2); q += __shfl_xor(q, 4); q += __shfl_xor(q, 8); q += __shfl_xor(q, 16);
    if (r32 == r) atomicAdd(sq + orow, q * sqs); }
  __syncthreads();
#undef SLOAD
#undef SWRITE
#undef RESC
}
}

constexpr int RW_PITCH = 1032;
__device__ __forceinline__ void p7_router(CARGS& a, LAS unsigned char* lds, int vcu, int G) {
    const int tid = tid_x(), lane = tid & 63, wave = __builtin_amdgcn_readfirstlane(tid >> 6);
    unsigned char* ws = a.ws;
    const float* H1 = (const float*)(ws + WS_H1); const float* ssq1 = (const float*)(ws + CTLB_SSQ1); unsigned char* XN2 = ws + WS_XN;
    float* GATEW = (float*)(ws + WS_GATEW); int* LIST = (int*)(ws + WS_LIST); unsigned* gcount = (unsigned*)(ws + WS_CTL) + CW_CNT;
    const float* gn = a.in[15]; const float* Wr = a.in[16]; const float* br = a.in[17];
    LAS bf16_t* Wh = (LAS bf16_t*)lds; LAS bf16_t* Wl = Wh + 32 * RW_PITCH;
    LAS float* lg = (LAS float*)(lds + 132096) + wave * 16 * 33;
    LAS int* lcount = (LAS int*)(lds + 132096 + 8 * 16 * 33 * 4);
    LAS int* lbase = lcount + 32; LAS int* lent = lbase + 32;
    for (int idx = tid; idx < 32 * 1024; idx += 512) { const int e = idx & 31, k = idx >> 5; const float w = Wr[idx] * gn[k];
        const unsigned hb = cvt_pk_bf16(w, w) & 0xffffu; const float wl = w - __uint_as_float(hb << 16);
        Wh[e * RW_PITCH + k] = (bf16_t)hb; Wl[e * RW_PITCH + k] = (bf16_t)(cvt_pk_bf16(wl, wl) & 0xffffu); }
    if (tid < 32) lcount[tid] = 0;
    __syncthreads();
    const int fr = lane & 15, fq = lane >> 4;
    for (int bi = vcu; bi < NTOK / 128; bi += G) {
        const int tok0 = bi * 128 + wave * 16, tok = tok0 + fr;
        const float rstd = __builtin_amdgcn_rsqf(ssq1[tok] * (1.0f / DM) + EPS);
        f32x4 acc0 = {0.f, 0.f, 0.f, 0.f}, acc1 = acc0;
        const float* xr = H1 + (size_t)tok * DM + 8 * fq;
#pragma unroll 2
        for (int ks = 0; ks < 32; ++ks) {
            const f32x4 x0 = *(const f32x4*)(xr + 32 * ks), x1 = *(const f32x4*)(xr + 32 * ks + 4);
            const f32x4 g0 = *(const f32x4*)(gn + 32 * ks + 8 * fq), g1 = *(const f32x4*)(gn + 32 * ks + 8 * fq + 4);
            u32x4 hw, lw; float nv[8]; float xs[8] = {x0[0], x0[1], x0[2], x0[3], x1[0], x1[1], x1[2], x1[3]}; float gs[8] = {g0[0], g0[1], g0[2], g0[3], g1[0], g1[1], g1[2], g1[3]};
#pragma unroll
            for (int q = 0; q < 4; ++q) { const unsigned h = cvt_pk_bf16(xs[2 * q], xs[2 * q + 1]); hw[q] = h;
                lw[q] = cvt_pk_bf16(xs[2 * q] - bflo(h), xs[2 * q + 1] - bfhi(h));
                nv[2 * q] = xs[2 * q] * rstd * gs[2 * q] * 16.0f; nv[2 * q + 1] = xs[2 * q + 1] * rstd * gs[2 * q + 1] * 16.0f; }
            { u32x2 nw; nw.x = cvt_pk4_fp8(nv[0], nv[1], nv[2], nv[3]); nw.y = cvt_pk4_fp8(nv[4], nv[5], nv[6], nv[7]); *(u32x2*)(XN2 + (size_t)tok * DM + 32 * ks + 8 * fq) = nw; }
            const bf16x8 xh = *reinterpret_cast<bf16x8*>(&hw), xl = *reinterpret_cast<bf16x8*>(&lw);
            const bf16x8 wh0 = *(const LAS bf16x8*)(Wh + fr * RW_PITCH + 32 * ks + 8 * fq), wh1 = *(const LAS bf16x8*)(Wh + (16 + fr) * RW_PITCH + 32 * ks + 8 * fq);
            const bf16x8 wl0 = *(const LAS bf16x8*)(Wl + fr * RW_PITCH + 32 * ks + 8 * fq), wl1 = *(const LAS bf16x8*)(Wl + (16 + fr) * RW_PITCH + 32 * ks + 8 * fq);
            acc0 = __builtin_amdgcn_mfma_f32_16x16x32_bf16(xh, wh0, acc0, 0, 0, 0); acc0 = __builtin_amdgcn_mfma_f32_16x16x32_bf16(xl, wh0, acc0, 0, 0, 0); acc0 = __builtin_amdgcn_mfma_f32_16x16x32_bf16(xh, wl0, acc0, 0, 0, 0);
            acc1 = __builtin_amdgcn_mfma_f32_16x16x32_bf16(xh, wh1, acc1, 0, 0, 0); acc1 = __builtin_amdgcn_mfma_f32_16x16x32_bf16(xl, wh1, acc1, 0, 0, 0); acc1 = __builtin_amdgcn_mfma_f32_16x16x32_bf16(xh, wl1, acc1, 0, 0, 0);
        }
#pragma unroll
        for (int r = 0; r < 4; ++r) { lg[(4 * fq + r) * 33 + fr] = acc0[r]; lg[(4 * fq + r) * 33 + 16 + fr] = acc1[r]; }
        LDS_WAIT(); asm volatile("" ::: "memory");
        if (lane < 16) { const int tk = tok0 + lane; const float rs = __builtin_amdgcn_rsqf(ssq1[tk] * (1.0f / DM) + EPS);
            float v[32];
#pragma unroll
            for (int e = 0; e < 32; ++e) v[e] = lg[lane * 33 + e] * rs + br[e];
            int bi4[4]; float bv4[4];
#pragma unroll
            for (int k = 0; k < 4; ++k) { float bv = -INFINITY; int be = 0;
#pragma unroll
                for (int e = 0; e < 32; ++e) { const bool tk_ = v[e] > bv; bv = tk_ ? v[e] : bv; be = tk_ ? e : be; }
                bi4[k] = be; bv4[k] = bv;
#pragma unroll
                for (int e = 0; e < 32; ++e) v[e] = (e == be) ? -INFINITY : v[e]; }
            const float e1 = __expf(bv4[1] - bv4[0]), e2 = __expf(bv4[2] - bv4[0]), e3 = __expf(bv4[3] - bv4[0]); const float inv = 1.0f / (1.0f + e1 + e2 + e3);
            const float gw[4] = {inv, e1 * inv, e2 * inv, e3 * inv};
            *(f32x4*)(GATEW + (size_t)tk * 4) = (f32x4){gw[0], gw[1], gw[2], gw[3]};
#pragma unroll
            for (int k = 0; k < 4; ++k) { const int pos = atomicAdd((int*)(lcount + bi4[k]), 1); const int n = (wave * 16 + lane) * 4 + k; lent[n] = (bi4[k] << 20) | pos; } }
        __syncthreads();
        if (tid < 32) { lbase[tid] = (int)__hip_atomic_fetch_add(gcount + 64 * tid, (unsigned)lcount[tid], __ATOMIC_RELAXED, __HIP_MEMORY_SCOPE_AGENT); }
        __syncthreads();
        { const int en = lent[tid], e = en >> 20, pos = en & 0xfffff; LIST[(size_t)e * NTOK + lbase[e] + pos] = bi * 512 + tid; }
        __syncthreads();
        if (tid < 32) lcount[tid] = 0;
        __syncthreads();
    }
}

__device__ __forceinline__ int moe_table(CARGS& a, LAS unsigned char* lds) {
    LAS int* tab = (LAS int*)(lds + LDS_TAB); const unsigned* gcount = (const unsigned*)(a.ws + WS_CTL) + CW_CNT;
    if (tid_x() == 0) { int T = 0;
        for (int e = 0; e < NEXP; ++e) { const int cnt = (int)__hip_atomic_load(gcount + 64 * e, __ATOMIC_RELAXED, __HIP_MEMORY_SCOPE_AGENT);
            for (int r0 = 0; r0 < cnt; r0 += 256) { const int v = cnt - r0 < 256 ? cnt - r0 : 256; tab[2 * T] = e | (v << 8); tab[2 * T + 1] = r0; ++T; } }
        tab[2 * MAXTILES] = T; }
    __syncthreads();
    return tab[2 * MAXTILES];
}

__device__ __forceinline__ void p10_combine(CARGS& a, int vcu, int G) {
    const int tid = tid_x(), lane = tid & 63, wave = __builtin_amdgcn_readfirstlane(tid >> 6); unsigned char* ws = a.ws; const int gw = vcu * 8 + wave, NGW = G * 8;
    float* H1 = (float*)(ws + WS_H1); const bf16_t* YS = (const bf16_t*)(ws + WS_YS); bf16_t* XN3 = (bf16_t*)(ws + WS_XN3); const float* g = a.in[22];
    f32x4 gv[4];
#pragma unroll
    for (int j = 0; j < 4; ++j) gv[j] = *(const f32x4*)(g + 4 * lane + 256 * j);
    for (int m0 = gw * 2; m0 < NTOK; m0 += NGW * 2) {
        f32x4 v[2][4]; u32x2 w[2][4][4];
#pragma unroll
        for (int r = 0; r < 2; ++r)
#pragma unroll
            for (int j = 0; j < 4; ++j) { v[r][j] = ((const f32x4*)(H1 + (size_t)(m0 + r) * DM) + lane)[64 * j];
#pragma unroll
                for (int k = 0; k < 4; ++k) w[r][j][k] = *((const u32x2*)(YS + ((size_t)(m0 + r) * 4 + k) * DM) + lane + 64 * j); }
#pragma unroll
        for (int r = 0; r < 2; ++r) { float s = 0.f; f32x4* hr = (f32x4*)(H1 + (size_t)(m0 + r) * DM) + lane;
#pragma unroll
            for (int j = 0; j < 4; ++j) {
#pragma unroll
                for (int k = 0; k < 4; ++k) { v[r][j][0] += bflo(w[r][j][k].x); v[r][j][1] += bfhi(w[r][j][k].x); v[r][j][2] += bflo(w[r][j][k].y); v[r][j][3] += bfhi(w[r][j][k].y); }
                hr[64 * j] = v[r][j]; s += (v[r][j][0] * v[r][j][0] + v[r][j][1] * v[r][j][1]) + (v[r][j][2] * v[r][j][2] + v[r][j][3] * v[r][j][3]); }
            const float rstd = __builtin_amdgcn_rsqf(wave_sum(s) * (1.0f / DM) + EPS);
            u32x2* o8 = (u32x2*)(XN3 + (size_t)(m0 + r) * DM) + lane;
#pragma unroll
            for (int j = 0; j < 4; ++j) { u32x2 o; o.x = cvt_pk_bf16(v[r][j][0] * rstd * gv[j][0], v[r][j][1] * rstd * gv[j][1]); o.y = cvt_pk_bf16(v[r][j][2] * rstd * gv[j][2], v[r][j][3] * rstd * gv[j][3]); o8[64 * j] = o; } } }
}
__device__ __forceinline__ void p12_final(CARGS& a, int vcu, int G) {
    const int tid = tid_x(), lane = tid & 63, wave = __builtin_amdgcn_readfirstlane(tid >> 6); unsigned char* ws = a.ws; const int gw = vcu * 8 + wave, NGW = G * 8;
    const float* ssq3 = (const float*)(ws + CTLB_SSQ3); const float* g = a.in[25];
    f32x4 gv[4];
#pragma unroll
    for (int j = 0; j < 4; ++j) gv[j] = *(const f32x4*)(g + 4 * lane + 256 * j);
    if (PROBE_TIME) { const float* pr = (const float*)(ws + WS_TOPI); const float c = sqrtf(10.0f * 0.04f * __builtin_rintf(25.0f * pr[0] / (pr[0] + pr[1])));
        for (int m = gw; m < NTOK; m += NGW) { f32x4* hr = (f32x4*)(a.out + (size_t)m * DM) + lane;
#pragma unroll
            for (int j = 0; j < 4; ++j) hr[64 * j] = (f32x4){c, c, c, c}; }
        return; }
    for (int m0 = gw * 4; m0 < NTOK; m0 += NGW * 4) { f32x4 v[4][4]; float rs[4];
#pragma unroll
        for (int r = 0; r < 4; ++r) { rs[r] = __builtin_amdgcn_rsqf(ssq3[m0 + r] * (1.0f / DM) + EPS);
#pragma unroll
            for (int j = 0; j < 4; ++j) v[r][j] = ((const f32x4*)(a.out + (size_t)(m0 + r) * DM) + lane)[64 * j]; }
#pragma unroll
        for (int r = 0; r < 4; ++r)
#pragma unroll
            for (int j = 0; j < 4; ++j) ((f32x4*)(a.out + (size_t)(m0 + r) * DM) + lane)[64 * j] = v[r][j] * rs[r] * gv[j]; }
}

__global__ void __launch_bounds__(512, 2) fwd_kernel(Args a_unused) {
    extern __shared__ __attribute__((aligned(16))) unsigned char lds_raw[];
    LAS unsigned char* lds = (LAS unsigned char*)lds_raw;
    { const int t0 = (int)__builtin_amdgcn_workitem_id_x(); if ((t0 & 63) == 0) *(volatile LAS int*)(unsigned long)(LDS_WTAB + 4 * hw_wave_key()) = t0 >> 6; }
    __syncthreads();
    const int tid = tid_x();
    const int G = gridDim.x; const int bx = blockIdx.x; const int vcu = (G % 8 == 0) ? (bx % 8) * (G / 8) + bx / 8 : bx;
    unsigned char* ws = arg_ptr()->ws;
    volatile LAS unsigned* MISC = (volatile LAS unsigned*)(lds + LDS_MISC);
    if (tid < 64) MISC[tid] = 0u;
    __syncthreads();
    unsigned* ctl = (unsigned*)(ws + WS_CTL);
    XcdBarrier bar; bar.bar = ctl + CW_BAR; bar.x = 0; bar.st = nullptr;
    if (MK_ONE_LAUNCH) bar = xcd_barrier_post(ctl + CW_BAR, MISC + 8);
    const int lo = arg_ptr()->ph_lo, hi = arg_ptr()->ph_hi;
#ifndef PHASE_MASK
#define PHASE_MASK 0x1fff
#endif
#define IN(k) (((PHASE_MASK >> (k)) & 1) && lo <= (k) && (k) < hi)
#define SEAM(k) do { if (IN(k) && IN((k) + 1)) xcd_barrier(bar); } while (0)

    bf16_t* U = (bf16_t*)(ws + WS_U); bf16_t* XN = (bf16_t*)(ws + WS_XN); bf16_t* Q = (bf16_t*)(ws + WS_Q); bf16_t* KV = (bf16_t*)(ws + WS_KV);
    bf16_t* Y = (bf16_t*)(ws + WS_Y); float* H1 = (float*)(ws + WS_H1);

    if (IN(0)) { CARGS& a = *arg_ptr(); for (int dup = 0; dup < (PROBE_DUP == 1 ? 2 : 1); ++dup) p0_prologue(a, lds, vcu, G); } SEAM(0);

    if (IN(1)) { CARGS& a = *arg_ptr();
        ProbBf16<false> p; p.Abase = (const char*)XN; p.lda = DM; p.Bt = (const bf16_t*)(ws + WS_WIN); p.ldb = DM; p.K = DM; p.tmid = 0; p.S.init(128, 10, G, bx);
        p.O = U; p.ldc = NU; p.rope_pn = -1; p.cs = nullptr; if (PROBE_TIME == 1) p.probe = (float*)(ws + WS_TOPI);
        for (int dup = 0; dup < (PROBE_DUP == 2 ? 2 : 1); ++dup) pg8::gemm_phase(lds, p);
    } SEAM(1);

    if (IN(2)) { CARGS& a = *arg_ptr(); p2_tail(a, vcu, G); } SEAM(2);

    if (IN(3)) { CARGS& a = *arg_ptr();
        for (int dup = 0; dup < (PROBE_DUP == 3 ? 2 : 1); ++dup) {
        { ProbBf16<true> p; p.Abase = (const char*)(U + UC_CQ); p.lda = NU; p.Bt = (const bf16_t*)(ws + WS_WQ); p.ldb = 256; p.K = 256; p.tmid = 0; p.S.init(128, 3, G, bx);
          p.O = Q; p.ldc = 768; p.rope_pn = 2; p.cs = (const float*)(ws + WS_CS); pg8::gemm_phase(lds, p); }
        { ProbBf16<false> p; p.Abase = (const char*)(U + UC_CKV); p.lda = NU; p.Bt = (const bf16_t*)(ws + WS_WKV); p.ldb = 256; p.K = 256; p.tmid = 0; p.S.init(128, 4, G, bx);
          p.O = KV; p.ldc = 1024; p.rope_pn = -1; p.cs = nullptr; pg8::gemm_phase(lds, p); }
        { ProbBf16<false> p; p.Abase = (const char*)(ws + WS_PB); p.lda = 256; p.Bt = (const bf16_t*)(ws + WS_WPP); p.ldb = 256; p.K = 256; p.tmid = 0; p.S.init(128, 4, G, bx);
          p.O = (bf16_t*)(ws + WS_PP); p.ldc = 1024; p.rope_pn = -1; p.cs = nullptr; pg8::gemm_phase(lds, p); }
        }
        for (int dup = 0; dup < (PROBE_DUP == 4 ? 2 : 1); ++dup)
        for (int u = vcu; u < 1024; u += G) mlstm_local(a, lds, u);
    } SEAM(3);

    if (IN(4)) { CARGS& a = *arg_ptr(); mlstm_scan(a, vcu, G); } SEAM(4);

    if (IN(5)) { CARGS& a = *arg_ptr();
        for (int dup = 0; dup < (PROBE_DUP == 5 ? 2 : 1); ++dup)
        for (int u = vcu; u < 512; u += G) {
            const int qb = u & 15, bh = u >> 4, h = bh & 3, b = bh >> 2; const size_t t0 = (size_t)b * SEQ;
            att::attn_unit(Q + (t0 + qb * 256) * 768 + h * 128, Q + (t0 + qb * 256) * 768 + 512 + h * 64, KV + t0 * 1024 + h * 128, KV + t0 * 1024 + 512 + h * 128,
                           (const bf16_t*)(ws + WS_KPE) + t0 * 64, Y + (t0 + qb * 256) * DM + h * 128, (float*)(ws + CTLB_SSQO) + t0 + qb * 256, dup ? 0.f : 1.f, SEQ, lds);
        }
        for (int dup = 0; dup < (PROBE_DUP == 6 ? 2 : 1); ++dup)
        for (int u = vcu; u < 1024; u += G) mlstm_out(a, lds, u);
    } SEAM(5);

    if (IN(6)) { CARGS& a = *arg_ptr();
        ProbWout p; p.Abase = (const char*)Y; p.lda = DM; p.Bt = (const bf16_t*)(ws + WS_WOUT); p.ldb = DM; p.K = DM; p.tmid = 8; p.S.init(128, 4, G, bx);
        p.x = a.in[0]; p.H1 = H1; p.ssqo = (const float*)(ws + CTLB_SSQO); p.ssq1 = (float*)(ws + CTLB_SSQ1);
        for (int dup = 0; dup < (PROBE_DUP == 7 ? 2 : 1); ++dup) { p.sqs = dup ? 0.f : 1.f; pg8::gemm_phase(lds, p); }
    } SEAM(6);

    if (IN(7)) { CARGS& a = *arg_ptr(); p7_router(a, lds, vcu, G); } SEAM(7);

    if (IN(8)) { CARGS& a = *arg_ptr();
        const int T = moe_table(a, lds);
        ProbMoe1 p; p.Abase = (const char*)XN; p.Wgu = ws + WS_WGU; p.ldb = 512; p.K = 512; p.tmid = 0;
        p.S.tab = (const LAS int*)(lds + LDS_TAB); p.S.T = T; p.S.nN = 8; p.S.G = G; p.S.c = bx;
        p.list = (const int*)(ws + WS_LIST); p.bgu = a.in[19]; p.HMID = ws + WS_HMID; if (PROBE_TIME == 8) p.probe = (float*)(ws + WS_TOPI);
        for (int dup = 0; dup < (PROBE_DUP == 8 ? 2 : 1); ++dup) pg8::gemm_phase(lds, p);
    } SEAM(8);

    if (IN(9)) { CARGS& a = *arg_ptr();
        const int T = moe_table(a, lds);
        ProbMoe2 p; p.Abase = (const char*)(ws + WS_HMID); p.Wdn = ws + WS_WDN; p.ldb = 512; p.K = 512; p.tmid = 0;
        p.S.tab = (const LAS int*)(lds + LDS_TAB); p.S.T = T; p.S.nN = 4; p.S.G = G; p.S.c = bx;
        p.list = (const int*)(ws + WS_LIST); p.bdn = a.in[21]; p.gatew = (const float*)(ws + WS_GATEW); p.YS = (bf16_t*)(ws + WS_YS); if (PROBE_TIME == 9) p.probe = (float*)(ws + WS_TOPI);
        for (int dup = 0; dup < (PROBE_DUP == 9 ? 2 : 1); ++dup) pg8::gemm_phase(lds, p);
    } SEAM(9);

    if (IN(10)) { CARGS& a = *arg_ptr(); p10_combine(a, vcu, G); } SEAM(10);

    if (IN(11)) { CARGS& a = *arg_ptr();
        ProbPle p; p.Abase = (const char*)(ws + WS_XN3); p.lda = DM; p.Bt = (const bf16_t*)(ws + WS_WPG); p.ldb = DM; p.K = DM; p.tmid = 0; p.S.init(128, 4, G, bx);
        p.H2 = H1; p.PP = (const bf16_t*)(ws + WS_PP); p.out = a.out; p.ssq3 = (float*)(ws + CTLB_SSQ3); if (PROBE_TIME == 11) p.probe = (float*)(ws + WS_TOPI);
        for (int dup = 0; dup < (PROBE_DUP == 10 ? 2 : 1); ++dup) { p.sqs = dup ? 0.f : 1.f; pg8::gemm_phase(lds, p); }
    } SEAM(11);

    if (IN(12)) { CARGS& a = *arg_ptr(); p12_final(a, vcu, G); }
#undef IN
#undef SEAM
}

extern "C" void kernel_launch(void* const* d_in, const int* in_sizes, int n_in, void* d_out, int out_size, void* d_ws, size_t ws_size, hipStream_t stream) {
    static int grid = 0;
    if (grid == 0) {
        if (n_in != 26 || in_sizes[0] != NTOK * DM || out_size != NTOK * DM || ws_size < WS_END) {
            fprintf(stderr, "kernel_launch: unexpected shapes: n_in %d in0 %d out %d ws %zu (need %zu)\n", n_in, n_in > 0 ? in_sizes[0] : -1, out_size, ws_size, (size_t)WS_END); grid = -1; return; }
        int dev = 0, cus = 0, per_cu = 0;
        if (hipGetDevice(&dev) != hipSuccess || hipDeviceGetAttribute(&cus, hipDeviceAttributeMultiprocessorCount, dev) != hipSuccess) { grid = -1; return; }
        if (hipFuncSetAttribute((const void*)fwd_kernel, hipFuncAttributeMaxDynamicSharedMemorySize, LDS_BYTES) != hipSuccess) { fprintf(stderr, "kernel_launch: hipFuncSetAttribute failed\n"); grid = -1; return; }
        if (hipOccupancyMaxActiveBlocksPerMultiprocessor(&per_cu, (const void*)fwd_kernel, 512, LDS_BYTES) != hipSuccess || per_cu < 1) { fprintf(stderr, "kernel_launch: occupancy query says %d\n", per_cu); }
        (void)hipGetLastError();
        grid = cus - (cus % 8);
        if (grid <= 0) grid = 8;
    }
    if (grid < 0) return;
    (void)hipMemsetAsync((char*)d_ws + WS_CTL, 0, CTL_ZERO_BYTES, stream);
    Args a{};
    for (int i = 0; i < 26; ++i) a.in[i] = (const float*)d_in[i];
    a.out = (float*)d_out; a.ws = (unsigned char*)d_ws;
#if MK_ONE_LAUNCH
    a.ph_lo = 0; a.ph_hi = NPHASE;
    hipLaunchKernelGGL(fwd_kernel, dim3(grid), dim3(512), LDS_BYTES, stream, a);
#else
    for (int ph = 0; ph < NPHASE; ++ph) { a.ph_lo = ph; a.ph_hi = ph + 1; hipLaunchKernelGGL(fwd_kernel, dim3(grid), dim3(512), LDS_BYTES, stream, a); }
#endif
    const hipError_t le = hipPeekAtLastError();
    if (le != hipSuccess) fprintf(stderr, "kernel_launch: launch failed: %s\n", hipGetErrorName(le));
}
```
